# Optimizing an MI355X kernel written in HIP

```python
import math
import jax
import jax.numpy as jnp
from jax import lax
import numpy as np


D_MODEL = 1024
BATCH = 16
SEQ = 2048
DEPTH = 1

MIX_WIDTH = D_MODEL
MLSTM_WIDTH = MIX_WIDTH // 2
ATTN_WIDTH = MIX_WIDTH - MLSTM_WIDTH
MLSTM_HEADS = 4
MLSTM_HEAD_DIM = MLSTM_WIDTH // MLSTM_HEADS
MLSTM_QKV_BLOCK = 4
MLSTM_CONV = 5
MLSTM_CHUNK = 64
ATTN_HEAD_DIM = 64
ATTN_HEADS = ATTN_WIDTH // ATTN_HEAD_DIM
DILATED_PATTERNS = ((128, 1), (512, 4), (2048, 16))
ATTN_BLOCK = 64
REL_BUCKETS = 32
REL_MAX_DIST = 1024
N_EXPERTS = 16
EC_CAPACITY_FACTOR = 2
D_FF_EXPERT = 2 * D_MODEL
NORM_EPS = 1e-6
N_MOD = 6
PROJ_WIDTHS = (MLSTM_WIDTH, MLSTM_WIDTH, MLSTM_HEADS, MLSTM_HEADS, MLSTM_HEADS, MLSTM_HEADS,
               ATTN_WIDTH, ATTN_WIDTH, ATTN_WIDTH)
PROJ_TOTAL = sum(PROJ_WIDTHS)

kernel_name = "hybrid_mlstm_dilated_attn_ec_moe"


def rms_norm(x, g):
    xf = x.astype(jnp.float32)
    y = xf * lax.rsqrt(jnp.mean(xf * xf, axis=-1, keepdims=True) + NORM_EPS)
    return (y * g.astype(jnp.float32)).astype(x.dtype)


def t5_bucket(rel):
    half = REL_BUCKETS // 2
    exact = half // 2
    n = jnp.abs(rel)
    log_ratio = jnp.log(jnp.maximum(n, 1).astype(jnp.float32) / exact) / math.log(REL_MAX_DIST / exact)
    large = jnp.minimum(exact + (log_ratio * (half - exact)).astype(jnp.int32), half - 1)
    return jnp.where(rel > 0, half, 0) + jnp.where(n < exact, n, large)


def dilated_window_attention(q, k, v, rel_bias, window, dilation):
    B, S, H, E = q.shape
    half = window // (2 * dilation)
    L = S // dilation
    nb = -(-L // ATTN_BLOCK)
    pad = nb * ATTN_BLOCK - L

    def phases(t):
        return t.reshape(B, L, dilation, H, E).transpose(0, 2, 3, 1, 4).reshape(B * dilation, H, L, E)

    qb = jnp.pad(phases(q), ((0, 0), (0, 0), (0, pad), (0, 0))).reshape(B * dilation, H, nb, ATTN_BLOCK, E)

    def key_blocks(t):
        tp = jnp.pad(phases(t), ((0, 0), (0, 0), (ATTN_BLOCK, pad + ATTN_BLOCK), (0, 0)))
        tp = tp.reshape(B * dilation, H, nb + 2, ATTN_BLOCK, E)
        return jnp.concatenate([tp[:, :, 0:nb], tp[:, :, 1:nb + 1], tp[:, :, 2:nb + 2]], axis=3)

    kb, vb = key_blocks(k), key_blocks(v)
    qi = jnp.arange(ATTN_BLOCK)[:, None]
    kj = jnp.arange(3 * ATTN_BLOCK)[None, :] - ATTN_BLOCK
    rel = kj - qi
    key_pos = jnp.arange(nb)[:, None] * ATTN_BLOCK + kj
    valid = (jnp.abs(rel) <= half)[None] & ((key_pos >= 0) & (key_pos < L))[:, None, :]
    bias = rel_bias[t5_bucket(rel * dilation)].transpose(2, 0, 1).astype(jnp.float32)
    logits = jnp.einsum('nhcqe,nhcke->nhcqk', qb, kb).astype(jnp.float32) / math.sqrt(E) + bias[:, None]
    logits = jnp.where(valid, logits, -jnp.inf)
    lse = jax.nn.logsumexp(logits, axis=-1)
    p = jnp.exp(logits - lse[..., None]).astype(v.dtype)
    o = jnp.einsum('nhcqk,nhcke->nhcqe', p, vb)
    o = o.reshape(B * dilation, H, nb * ATTN_BLOCK, E)[:, :, :L]
    o = o.reshape(B, dilation, H, L, E).transpose(0, 3, 1, 2, 4).reshape(B, S, H, E)
    lse = lse.reshape(B * dilation, H, nb * ATTN_BLOCK)[:, :, :L]
    lse = lse.reshape(B, dilation, H, L).transpose(0, 3, 1, 2).reshape(B, S, H)
    return o, lse


def dilated_attention_mixer(a_q, a_k, a_v, q_norm_g, k_norm_g, rel_bias):
    B, S, _ = a_q.shape
    heads = lambda t: t.reshape(B, S, ATTN_HEADS, ATTN_HEAD_DIM)
    q = rms_norm(heads(a_q), q_norm_g)
    k = rms_norm(heads(a_k), k_norm_g)
    v = heads(a_v)
    outs, lses = zip(*[dilated_window_attention(q, k, v, rel_bias, w, d) for w, d in DILATED_PATTERNS])
    weights = jax.nn.softmax(jnp.stack(lses), axis=0)
    o = jnp.sum(weights[..., None] * jnp.stack(outs).astype(jnp.float32), axis=0)
    return o.reshape(B, S, ATTN_WIDTH).astype(a_q.dtype)


def mlstm_chunkwise(q, k, v, i_pre, log_f):
    B, H, S, E = q.shape
    NC = S // MLSTM_CHUNK
    ch = lambda t: t.reshape((B, H, NC, MLSTM_CHUNK) + t.shape[3:])
    q, k, v, i_pre, log_f = ch(q), ch(k), ch(v), ch(i_pre), ch(log_f)
    b = jnp.cumsum(log_f, axis=-1)
    g = b[..., -1]
    a = g[..., None] - b + i_pre

    def step(carry, xs):
        C, n, m = carry
        kc, vc, ac, gc = xs
        m_new = jnp.maximum(gc + m, jnp.max(ac, axis=-1))
        w = jnp.exp(ac - m_new[..., None])
        decay = jnp.exp(gc + m - m_new)
        C_new = decay[..., None, None] * C + jnp.einsum('bhl,bhld,bhle->bhde', w, kc, vc)
        n_new = decay[..., None] * n + jnp.einsum('bhl,bhld->bhd', w, kc)
        return (C_new, n_new, m_new), (C, n, m)

    init = (jnp.zeros((B, H, E, E), jnp.float32), jnp.zeros((B, H, E), jnp.float32), jnp.zeros((B, H), jnp.float32))
    xs = tuple(jnp.moveaxis(t, 2, 0) for t in (k, v, a, g))
    _, (C_prev, n_prev, m_prev) = lax.scan(step, init, xs)
    C_prev = jnp.moveaxis(C_prev, 0, 2)
    n_prev = jnp.moveaxis(n_prev, 0, 2)
    m_prev = jnp.moveaxis(m_prev, 0, 2)

    lower = jnp.tril(jnp.ones((MLSTM_CHUNK, MLSTM_CHUNK), dtype=bool))
    D = jnp.where(lower, b[..., :, None] - b[..., None, :] + i_pre[..., None, :], -jnp.inf)
    inter = b + m_prev[..., None]
    m_t = jnp.maximum(inter, jnp.max(D, axis=-1))
    w_intra = jnp.exp(D - m_t[..., None]) * jnp.einsum('bhcte,bhcje->bhctj', q, k)
    w_inter = jnp.exp(inter - m_t)
    num = w_inter[..., None] * jnp.einsum('bhcte,bhced->bhctd', q, C_prev) + jnp.einsum('bhctj,bhcjd->bhctd', w_intra, v)
    den = w_inter * jnp.einsum('bhcte,bhce->bhct', q, n_prev) + jnp.sum(w_intra, axis=-1)
    h = num / jnp.maximum(jnp.abs(den), jnp.exp(-m_t))[..., None]
    return h.reshape(B, H, S, E)


def mlstm_mixer(x_m, o_pre, i_fw, f_fw, i_bw, f_bw, conv_w, conv_b, w_q_blk, w_k_blk, w_v_blk,
                b_igate, b_fgate, out_norm_g, skip):
    B, S, _ = x_m.shape
    xc = lax.conv_general_dilated(x_m, conv_w[:, None, :], window_strides=(1,),
                                  padding=((MLSTM_CONV // 2, MLSTM_CONV // 2),),
                                  dimension_numbers=('NWC', 'WIO', 'NWC'),
                                  feature_group_count=MLSTM_WIDTH) + conv_b
    xc = jax.nn.silu(xc)

    def blockdiag(t, w):
        y = jnp.einsum('bsgi,gij->bsgj', t.reshape(B, S, -1, MLSTM_QKV_BLOCK), w)
        return y.reshape(B, S, MLSTM_HEADS, MLSTM_HEAD_DIM).transpose(0, 2, 1, 3).astype(jnp.float32)

    q = blockdiag(xc, w_q_blk)
    k = blockdiag(xc, w_k_blk) / math.sqrt(MLSTM_HEAD_DIM)
    v = blockdiag(x_m, w_v_blk)
    gate = lambda t, bias: (t.astype(jnp.float32) + bias.astype(jnp.float32)).transpose(0, 2, 1)
    i_f, logf_f = gate(i_fw, b_igate[0]), jax.nn.log_sigmoid(gate(f_fw, b_fgate[0]))
    i_b, logf_b = gate(i_bw, b_igate[1]), jax.nn.log_sigmoid(gate(f_bw, b_fgate[1]))
    flip = lambda t: jnp.flip(t, axis=2)
    h_fwd = mlstm_chunkwise(q, k, v, i_f, logf_f)
    h_bwd = flip(mlstm_chunkwise(flip(q), flip(k), flip(v), flip(i_b), flip(logf_b)))
    h = (h_fwd + h_bwd).transpose(0, 2, 1, 3)
    h = h * lax.rsqrt(jnp.mean(h * h, axis=-1, keepdims=True) + NORM_EPS)
    h = h * out_norm_g.astype(jnp.float32).reshape(MLSTM_HEADS, MLSTM_HEAD_DIM)
    h = h.reshape(B, S, MLSTM_WIDTH).astype(x_m.dtype) + skip * xc
    return h * jax.nn.sigmoid(o_pre)


def expert_choice_ffn(h, w_router, b_router, w_gate, w_up, w_down):
    B, S, D = h.shape
    cap = (EC_CAPACITY_FACTOR * S) // N_EXPERTS
    logits = (h @ w_router + b_router).astype(jnp.float32)
    affinity = jax.nn.softmax(logits, axis=-1)
    gates, idx = lax.top_k(affinity.transpose(0, 2, 1), cap)
    bidx = jnp.arange(B)[:, None, None]
    xin = h[bidx, idx]
    hid = jax.nn.silu(jnp.einsum('becd,edf->becf', xin, w_gate)) * jnp.einsum('becd,edf->becf', xin, w_up)
    y = jnp.einsum('becf,efd->becd', hid, w_down) * gates[..., None].astype(h.dtype)
    return jnp.zeros_like(h).at[bidx, idx].add(y)


def setup_inputs(seed: int = 0) -> dict:
    key = jax.random.key(seed)
    ks = jax.random.split(key, 26)
    f32 = jnp.float32
    nrm = lambda k, shape, scale: scale * jax.random.normal(k, shape, f32)
    L = DEPTH
    H = MLSTM_HEADS
    nblk = MLSTM_WIDTH // MLSTM_QKV_BLOCK
    return {
        "x": nrm(ks[0], (BATCH, SEQ, D_MODEL), 1.0),
        "c": nrm(ks[1], (BATCH, D_MODEL), 1.0),
        "w_ada": nrm(ks[2], (L, D_MODEL, N_MOD * D_MODEL), 0.5 * D_MODEL ** -0.5),
        "b_ada": nrm(ks[3], (L, N_MOD * D_MODEL), 0.02),
        "norm1_g": 1.0 + nrm(ks[4], (L, D_MODEL), 0.02),
        "w_in": nrm(ks[5], (L, D_MODEL, PROJ_TOTAL), D_MODEL ** -0.5),
        "conv_w": nrm(ks[6], (L, MLSTM_CONV, MLSTM_WIDTH), MLSTM_CONV ** -0.5),
        "conv_b": nrm(ks[7], (L, MLSTM_WIDTH), 0.02),
        "w_q_blk": nrm(ks[8], (L, nblk, MLSTM_QKV_BLOCK, MLSTM_QKV_BLOCK), MLSTM_QKV_BLOCK ** -0.5),
        "w_k_blk": nrm(ks[9], (L, nblk, MLSTM_QKV_BLOCK, MLSTM_QKV_BLOCK), MLSTM_QKV_BLOCK ** -0.5),
        "w_v_blk": nrm(ks[10], (L, nblk, MLSTM_QKV_BLOCK, MLSTM_QKV_BLOCK), MLSTM_QKV_BLOCK ** -0.5),
        "b_igate": nrm(ks[11], (L, 2, H), 0.1),
        "b_fgate": jnp.linspace(3.0, 6.0, H, dtype=f32)[None, None, :] + nrm(ks[12], (L, 2, H), 0.1),
        "mlstm_norm_g": 1.0 + nrm(ks[13], (L, MLSTM_WIDTH), 0.02),
        "mlstm_skip": 1.0 + nrm(ks[14], (L, MLSTM_WIDTH), 0.02),
        "q_norm_g": 1.0 + nrm(ks[15], (L, ATTN_HEAD_DIM), 0.02),
        "k_norm_g": 1.0 + nrm(ks[16], (L, ATTN_HEAD_DIM), 0.02),
        "rel_bias": nrm(ks[17], (REL_BUCKETS, ATTN_HEADS), 0.5),
        "w_out": nrm(ks[18], (L, MIX_WIDTH, D_MODEL), MIX_WIDTH ** -0.5),
        "norm2_g": 1.0 + nrm(ks[19], (L, D_MODEL), 0.02),
        "w_router": nrm(ks[20], (L, D_MODEL, N_EXPERTS), D_MODEL ** -0.5),
        "b_router": nrm(ks[21], (L, N_EXPERTS), 0.01),
        "w_gate": nrm(ks[22], (L, N_EXPERTS, D_MODEL, D_FF_EXPERT), D_MODEL ** -0.5),
        "w_up": nrm(ks[23], (L, N_EXPERTS, D_MODEL, D_FF_EXPERT), D_MODEL ** -0.5),
        "w_down": nrm(ks[24], (L, N_EXPERTS, D_FF_EXPERT, D_MODEL), D_FF_EXPERT ** -0.5),
    }


def reference(x, c, w_ada, b_ada, norm1_g, w_in, conv_w, conv_b, w_q_blk, w_k_blk, w_v_blk,
              b_igate, b_fgate, mlstm_norm_g, mlstm_skip, q_norm_g, k_norm_g, rel_bias, w_out,
              norm2_g, w_router, b_router, w_gate, w_up, w_down):
    split_points = [int(s) for s in np.cumsum(PROJ_WIDTHS)[:-1]]
    for l in range(DEPTH):
        mod = jax.nn.silu(c) @ w_ada[l] + b_ada[l]
        shift1, scale1, gate1, shift2, scale2, gate2 = jnp.split(mod[:, None, :], N_MOD, axis=-1)

        h = rms_norm(x, norm1_g[l]) * (1.0 + scale1) + shift1
        proj = h @ w_in[l]
        x_m, o_pre, i_fw, f_fw, i_bw, f_bw, a_q, a_k, a_v = jnp.split(proj, split_points, axis=-1)
        y_mlstm = mlstm_mixer(x_m, o_pre, i_fw, f_fw, i_bw, f_bw, conv_w[l], conv_b[l], w_q_blk[l],
                              w_k_blk[l], w_v_blk[l], b_igate[l], b_fgate[l], mlstm_norm_g[l], mlstm_skip[l])
        y_attn = dilated_attention_mixer(a_q, a_k, a_v, q_norm_g[l], k_norm_g[l], rel_bias)
        mix = jnp.concatenate([y_mlstm, y_attn], axis=-1) @ w_out[l]
        x = x + gate1 * mix

        h2 = rms_norm(x, norm2_g[l]) * (1.0 + scale2) + shift2
        x = x + gate2 * expert_choice_ffn(h2, w_router[l], b_router[l], w_gate[l], w_up[l], w_down[l])
    return x
```

```cpp
#include <hip/hip_runtime.h>
#include <cstdio>
#include <cstdint>

constexpr int NB = 16, S = 2048, D = 1024, T = NB * S;
constexpr int NPROJ = 2560, PROJ_TOTAL = 2576;
constexpr int NEXP = 16, CAP = 256, DFF = 2048;
constexpr float EPS = 1e-6f;

typedef unsigned short bf16_t;
typedef float f32x4 __attribute__((ext_vector_type(4)));
typedef unsigned u32x4 __attribute__((ext_vector_type(4)));
typedef unsigned u32x2 __attribute__((ext_vector_type(2)));

constexpr int KP = D + 64;
constexpr int HIDP = DFF + 64;
constexpr int PP = 512 + 64;
constexpr size_t MiB = 1u << 20;
constexpr size_t WS_CTL = 0;
constexpr size_t WS_MOD = 1 * MiB;
constexpr size_t WS_BIAS = 1 * MiB + 512 * 1024;
constexpr size_t WS_WIN = 2 * MiB;
constexpr size_t WS_WOUT = 8 * MiB;
constexpr size_t WS_AFF = 2 * MiB;
constexpr size_t WS_INV = 4 * MiB;
constexpr size_t WS_GSEL = 5 * MiB;
constexpr size_t WS_WG = 12 * MiB, WS_WU = 80 * MiB, WS_WD = 148 * MiB;
constexpr size_t WS_Y = 12 * MiB;
constexpr size_t WS_HB = 214 * MiB;
constexpr size_t WS_GATES = 282 * MiB;
constexpr size_t WS_PROJ = 284 * MiB, PROJ_STRIDE = 36 * MiB;
constexpr size_t WS_XM = WS_PROJ, WS_OPRE = WS_PROJ + PROJ_STRIDE, WS_AQ = WS_PROJ + 2 * PROJ_STRIDE, WS_AK = WS_PROJ + 3 * PROJ_STRIDE, WS_AV = WS_PROJ + 4 * PROJ_STRIDE;
constexpr size_t WS_MIX = 284 * MiB;
constexpr size_t WS_YCAT = 464 * MiB;
constexpr size_t WS_LSE = 532 * MiB;
constexpr size_t WS_HID = 282 * MiB;
constexpr size_t WS_END = 546 * MiB;
static_assert((size_t)2560 * KP * 2 <= 6 * MiB && (size_t)1024 * KP * 2 <= 4 * MiB && (size_t)16 * 2048 * KP * 2 <= 68 * MiB && (size_t)16 * 1024 * HIDP * 2 <= 66 * MiB, "weight copies");
static_assert((size_t)T * KP * 2 <= 68 * MiB && (size_t)T * PP * 2 <= 36 * MiB && WS_HID + (size_t)256 * 256 * HIDP * 2 <= WS_END && (size_t)256 * 256 * 1024 * 2 <= 136 * MiB && WS_LSE + (size_t)T * 8 * 4 <= WS_END, "activation buffers");

__device__ __forceinline__ float bf2f(bf16_t v) { return __uint_as_float(((unsigned)v) << 16); }
__device__ __forceinline__ bf16_t f2bf(float f) { unsigned u = __float_as_uint(f); return (bf16_t)((u + 0x7fffu + ((u >> 16) & 1u)) >> 16); }
__device__ __forceinline__ unsigned pk2(float lo, float hi) { unsigned r; asm("v_cvt_pk_bf16_f32 %0, %1, %2" : "=v"(r) : "v"(lo), "v"(hi)); return r; }
__device__ __forceinline__ float frcp(float x) { return __builtin_amdgcn_rcpf(x); }
__device__ __forceinline__ float fexp(float x) { return __builtin_amdgcn_exp2f(x * 1.4426950408889634f); }
__device__ __forceinline__ float fexp2(float x) { return __builtin_amdgcn_exp2f(x); }
__device__ __forceinline__ float wave_sum(float v) {
#pragma unroll
    for (int o = 1; o < 64; o <<= 1) v += __shfl_xor(v, o);
    return v;
}
__device__ __forceinline__ float silu_f(float x) { return x * __builtin_amdgcn_rcpf(1.0f + __expf(-x)); }
__device__ __forceinline__ float sigmoid_f(float x) { return __builtin_amdgcn_rcpf(1.0f + __expf(-x)); }
__device__ __forceinline__ float log_sigmoid_f(float z) { return fminf(z, 0.0f) - log1pf(__expf(-fabsf(z))); }

__device__ int t5_bucket(int rel) {
    const int n = rel < 0 ? -rel : rel;
    const float lr = logf((float)(n > 1 ? n : 1) / 8.0f) / 4.852030263919617f;
    int large = 8 + (int)(lr * 8.0f); if (large > 15) large = 15;
    return (rel > 0 ? 16 : 0) + (n < 8 ? n : large);
}

#define LAS __attribute__((address_space(3)))
typedef short bf16x8 __attribute__((ext_vector_type(8)));
constexpr int NWAVES = 8;
constexpr int RING_BYTES = 131072;
constexpr int LDS_BYTES = 163840;
constexpr int MISC_OFF = LDS_BYTES - 4096;
constexpr int TAB_OFF = MISC_OFF + 1024;

#define XB_TMO      128
#define XB_XCNT(j)  (256  + 64 * (j))
#define XB_XSUB(j)  (1280 + 64 * (j))
#define XB_XGEN(j)  (2304 + 64 * (j))
#define XB_TOP      3328
#define XB_TOPGEN   3392
#define XCD_BAR_WORDS 3456
#define XB_SPIN_CAP (1u << 18)
__device__ __forceinline__ unsigned xb_ld(unsigned* p)              { return __hip_atomic_load(p, __ATOMIC_RELAXED, __HIP_MEMORY_SCOPE_AGENT); }
__device__ __forceinline__ unsigned xb_add(unsigned* p, unsigned v) { return __hip_atomic_fetch_add(p, v, __ATOMIC_RELAXED, __HIP_MEMORY_SCOPE_AGENT); }
__device__ __forceinline__ unsigned xb_xcc_id() { return (unsigned)__builtin_amdgcn_s_getreg((3 << 11) | 20) & 0xFu; }
#define XB_SPIN(cond, bar) do { unsigned _sp = 0; while (cond) { __builtin_amdgcn_s_sleep(1); \
    if ((++_sp & 255u) == 0u) { if (xb_ld(&(bar)[XB_TMO])) break; if (_sp > XB_SPIN_CAP) { atomicAdd(&(bar)[XB_TMO], 1u); break; } } } } while (0)
struct XcdBarrier { unsigned* bar; unsigned x; volatile LAS unsigned* st; };
__device__ __forceinline__ XcdBarrier xcd_barrier_post(unsigned* bar, volatile LAS unsigned* st) {
    XcdBarrier b; b.bar = bar; b.x = xb_xcc_id(); b.st = st;
    if (threadIdx.x == 0) (void)xb_add(&bar[XB_XCNT(b.x)], 1u);
    return b;
}
__device__ __forceinline__ void xcd_barrier_complete(unsigned* bar, unsigned x, unsigned& nloc, unsigned& nx) {
    const unsigned G = gridDim.x * gridDim.y * gridDim.z;
    unsigned sum, cnt, mine, sp = 0u;
    for (;;) {
        sum = 0u; cnt = 0u; mine = 0u;
#pragma unroll
        for (unsigned j = 0; j < 16; ++j) { const unsigned c = xb_ld(&bar[XB_XCNT(j)]); sum += c; cnt += (c > 0u) ? 1u : 0u; mine = (j == x) ? c : mine; }
        if (sum == G) break;
        __builtin_amdgcn_s_sleep(1);
        if ((++sp & 255u) == 0u) { if (xb_ld(&bar[XB_TMO])) break; if (sp > XB_SPIN_CAP) { atomicAdd(&bar[XB_TMO], 1u); break; } }
    }
    nloc = mine > 0u ? mine : 1u; nx = cnt > 0u ? cnt : 1u;
}
__device__ __forceinline__ void xcd_barrier(const XcdBarrier& b) {
    asm volatile("s_waitcnt vmcnt(0)" ::: "memory");
    __syncthreads();
    if (threadIdx.x == 0) {
        unsigned* bar = b.bar;
        __builtin_amdgcn_s_waitcnt(0);
        unsigned nloc = b.st[0], nx = b.st[1];
        if (nloc == 0u) { xcd_barrier_complete(bar, b.x, nloc, nx); b.st[0] = nloc; b.st[1] = nx; }
        const unsigned old = xb_add(&bar[XB_XSUB(b.x)], 1u);
        const unsigned gen = old / nloc;
        if (old + 1u == (gen + 1u) * nloc) {
            __builtin_amdgcn_fence(__ATOMIC_RELEASE, "agent");
            asm volatile("s_waitcnt vmcnt(0)" ::: "memory");
            const unsigned og = xb_add(&bar[XB_TOP], 1u);
            const unsigned tg = og / nx;
            if (og + 1u == (tg + 1u) * nx) xb_add(&bar[XB_TOPGEN], 1u);
            else XB_SPIN(xb_ld(&bar[XB_TOPGEN]) == tg, bar);
            __builtin_amdgcn_fence(__ATOMIC_ACQUIRE, "agent");
            xb_add(&bar[XB_XGEN(b.x)], 1u);
            asm volatile("s_waitcnt vmcnt(0)" ::: "memory");
        } else {
            XB_SPIN(xb_ld(&bar[XB_XGEN(b.x)]) == gen, bar);
            __builtin_amdgcn_fence(__ATOMIC_ACQUIRE, "agent");
            asm volatile("s_waitcnt vmcnt(0)" ::: "memory");
        }
    }
    __syncthreads();
}

namespace pg {
constexpr int BM = 256, BK = 64, HALF = 128, HTB = HALF * BK * 2, STAGE_BYTES = 8 * HTB, NXCD = 8, WGM = 8;
__host__ __device__ __forceinline__ int lds_byte(int r, int c) { const int st = (r >> 4) * 2 + (c >> 5), rr = r & 15, cc = c & 31, ob = rr * 64 + cc * 2; return st * 1024 + (ob ^ (((ob >> 9) & 1) << 5)); }
__host__ __device__ __forceinline__ void stage_rc(int b, int& R, int& C) { const int st = b / 1024, sb = b % 1024, swz = sb ^ (((sb >> 9) & 1) << 5); R = (st >> 1) * 16 + swz / 64; C = (st & 1) * 32 + (swz % 64) / 2; }
__host__ __device__ __forceinline__ int perm32(int rho) { const int n = rho >> 4, i = rho & 15; return 8 * (i >> 2) + 4 * n + (i & 3); }
__device__ __forceinline__ unsigned cvt_pk_bf16(float lo, float hi) { unsigned r; asm volatile("v_cvt_pk_bf16_f32 %0, %1, %2" : "=v"(r) : "v"(lo), "v"(hi)); return r; }

struct Tile { const char* a0; const char* a1; const char* b0; const char* b1; };
__device__ __forceinline__ bool static_unit(int i, int G, int c, int nM, int nN, int& pm, int& pn) {
    const int nwg = nM * nN; const long L = (long)i * G + c; if (L >= nwg) return false;
    int wgid = (int)L; { const int q = nwg / NXCD, r = nwg % NXCD, xcd = wgid % NXCD, off = wgid / NXCD; wgid = (xcd < r ? xcd * (q + 1) : r * (q + 1) + (xcd - r) * q) + off; }
    const int nig = WGM * nN, gid = wgid / nig, fm = gid * WGM, gsz = (nM - fm) < WGM ? (nM - fm) : WGM;
    pm = fm + ((wgid % nig) % gsz); pn = (wgid % nig) / gsz; return true;
}
template <bool TR, class Tiles, class Epi>
__device__ __forceinline__ void gemm_stream(LAS unsigned char* lds, const int K, const Tiles& TS, const Epi& E, const unsigned (&voffA)[2][2], const unsigned (&voffB)[2]) {
    int tid = threadIdx.x; asm volatile("" : "+v"(tid));
    const int wid = __builtin_amdgcn_readfirstlane(tid >> 6), lane = tid & 63, wr = wid >> 2, wc = wid & 3, fr = lane & 15, fq = lane >> 4;
    const int nt = K / BK;
    const size_t kstep = (size_t)(BK * 2);
    const unsigned ldsw = (unsigned)wid * 1024u, ldsb = (unsigned)(unsigned long long)lds;
    const int aoff = lds_byte(wr * 64 + fr, fq * 8), boff = lds_byte(wc * 32 + fr, fq * 8);
#define PG_SA(b, h) (((b) * 2 + (h)) * HTB)
#define PG_SB(b, h) ((4 + (b) * 2 + (h)) * HTB)
#define PG_STAGE(bufoff, gbase, voff) do { const unsigned long long ga_ = (unsigned long long)(const char*)(gbase); \
        const unsigned long long gs_ = ((unsigned long long)(unsigned)__builtin_amdgcn_readfirstlane((unsigned)(ga_ >> 32)) << 32) | (unsigned long long)(unsigned)__builtin_amdgcn_readfirstlane((unsigned)ga_); \
        _Pragma("unroll") for (int _i = 0; _i < 2; ++_i) { unsigned keep_; const unsigned ld_ = (unsigned)__builtin_amdgcn_readfirstlane((int)(ldsb + (unsigned)(bufoff) + ldsw + _i * 8192)); \
            asm volatile("s_mov_b32 %0, m0\n\ts_mov_b32 m0, %3\n\ts_nop 0\n\tglobal_load_lds_dwordx4 %1, %2\n\ts_mov_b32 m0, %0" : "=&s"(keep_) : "v"((voff)[_i]), "s"(gs_), "s"(ld_) : "memory"); } } while (0)
#define PG_LDA(dst, b, h) do { _Pragma("unroll") for (int m = 0; m < 4; ++m) _Pragma("unroll") for (int k = 0; k < 2; ++k) dst[m][k] = *(const LAS bf16x8*)(lds + PG_SA(b, h) + aoff + m * 2048 + k * 1024); } while (0)
#define PG_LDB(dst, b, h) do { _Pragma("unroll") for (int n = 0; n < 2; ++n) _Pragma("unroll") for (int k = 0; k < 2; ++k) dst[n][k] = *(const LAS bf16x8*)(lds + PG_SB(b, h) + boff + n * 2048 + k * 1024); } while (0)
#define PG_MMA(ai, bj, At, Bt) do { __builtin_amdgcn_s_setprio(1); _Pragma("unroll") for (int m = 0; m < 4; ++m) _Pragma("unroll") for (int n = 0; n < 2; ++n) _Pragma("unroll") for (int k = 0; k < 2; ++k) \
        acc[ai][bj][m][n] = TR ? __builtin_amdgcn_mfma_f32_16x16x32_bf16(Bt[n][k], At[m][k], acc[ai][bj][m][n], 0, 0, 0) : __builtin_amdgcn_mfma_f32_16x16x32_bf16(At[m][k], Bt[n][k], acc[ai][bj][m][n], 0, 0, 0); __builtin_amdgcn_s_setprio(0); } while (0)
#define PG_WAIT_V(n) asm volatile("s_waitcnt vmcnt(" #n ")" ::: "memory")
#define PG_WAIT_L(n) asm volatile("s_waitcnt lgkmcnt(" #n ")" ::: "memory")
#define PG_BAR __builtin_amdgcn_s_barrier()
#define PG_SCHED __builtin_amdgcn_sched_barrier(0)
    Tile cur, nxt; int ui = 0;
    if (!TS.get(0, cur)) return;
    f32x4 acc[2][2][4][2];
#pragma unroll
    for (int a = 0; a < 2; ++a)
#pragma unroll
        for (int b = 0; b < 2; ++b)
#pragma unroll
            for (int m = 0; m < 4; ++m)
#pragma unroll
                for (int n = 0; n < 2; ++n) acc[a][b][m][n] = (f32x4){0.f, 0.f, 0.f, 0.f};
    bf16x8 At[4][2], B0[2][2], B1[2][2];
    PG_STAGE(PG_SB(0, 0), cur.b0, voffB); PG_STAGE(PG_SB(0, 1), cur.b1, voffB); PG_STAGE(PG_SA(0, 0), cur.a0, voffA[0]); PG_STAGE(PG_SA(0, 1), cur.a1, voffA[1]);
    if (wr == 1) PG_BAR;
    PG_WAIT_V(2); PG_BAR;
    PG_STAGE(PG_SB(1, 0), cur.b0 + kstep, voffB); PG_STAGE(PG_SA(1, 0), cur.a0 + kstep, voffA[0]); PG_STAGE(PG_SB(1, 1), cur.b1 + kstep, voffB);
    PG_WAIT_V(6); PG_BAR;
    for (;;) {
        const bool has_next = TS.get(ui + 1, nxt);
        if (!has_next) nxt = cur;
        for (int t = 0; t < nt; t += 2) {
            const bool last = (t == nt - 2);
            const char* a1h1 = cur.a1 + (size_t)(t + 1) * kstep;
            const char* a2h0 = last ? nxt.a0 : cur.a0 + (size_t)(t + 2) * kstep; const char* a2h1 = last ? nxt.a1 : cur.a1 + (size_t)(t + 2) * kstep;
            const char* b2h0 = last ? nxt.b0 : cur.b0 + (size_t)(t + 2) * kstep; const char* b2h1 = last ? nxt.b1 : cur.b1 + (size_t)(t + 2) * kstep;
            PG_LDB(B0, 0, 0); PG_LDB(B1, 0, 1); PG_SCHED; PG_LDA(At, 0, 0); PG_STAGE(PG_SA(1, 1), a1h1, voffA[1]);
            PG_WAIT_V(8); PG_WAIT_L(0); PG_BAR; PG_MMA(0, 0, At, B0); PG_MMA(0, 1, At, B1); PG_BAR; PG_SCHED;
            PG_LDA(At, 0, 1); PG_STAGE(PG_SB(0, 0), b2h0, voffB); PG_STAGE(PG_SB(0, 1), b2h1, voffB); PG_STAGE(PG_SA(0, 0), a2h0, voffA[0]);
            PG_WAIT_V(8); PG_WAIT_L(0); PG_BAR; PG_MMA(1, 0, At, B0); PG_MMA(1, 1, At, B1); PG_BAR; PG_SCHED;
            PG_LDB(B0, 1, 0); PG_LDB(B1, 1, 1); PG_SCHED; PG_LDA(At, 1, 0); PG_STAGE(PG_SA(0, 1), a2h1, voffA[1]);
            PG_WAIT_V(8); PG_WAIT_L(0); PG_BAR; PG_MMA(0, 0, At, B0); PG_MMA(0, 1, At, B1); PG_BAR; PG_SCHED;
            PG_LDA(At, 1, 1); PG_STAGE(PG_SB(1, 0), b2h0 + kstep, voffB); PG_STAGE(PG_SB(1, 1), b2h1 + kstep, voffB); PG_STAGE(PG_SA(1, 0), a2h0 + kstep, voffA[0]);
            PG_WAIT_V(8); PG_WAIT_L(0); PG_BAR; PG_MMA(1, 0, At, B0); PG_MMA(1, 1, At, B1); PG_BAR; PG_SCHED;
        }
        if (wr == 0) PG_BAR;
        E(acc, ui, wr, wc, fr, fq);
        if (!has_next) break;
#pragma unroll
        for (int a = 0; a < 2; ++a)
#pragma unroll
            for (int b = 0; b < 2; ++b)
#pragma unroll
                for (int m = 0; m < 4; ++m)
#pragma unroll
                    for (int n = 0; n < 2; ++n) acc[a][b][m][n] = (f32x4){0.f, 0.f, 0.f, 0.f};
        cur = nxt; ++ui;
        if (wr == 1) PG_BAR;
    }
    PG_WAIT_V(0);
    PG_BAR;
#undef PG_SA
#undef PG_SB
#undef PG_STAGE
#undef PG_LDA
#undef PG_LDB
#undef PG_MMA
#undef PG_WAIT_V
#undef PG_WAIT_L
#undef PG_BAR
#undef PG_SCHED
}
__device__ __forceinline__ void plain_voff(unsigned (&v)[2], int pitch, bool perm) {
    int tz = threadIdx.x; asm volatile("" : "+v"(tz));
#pragma unroll
    for (int i = 0; i < 2; ++i) { int R, C; stage_rc(tz * 16 + i * 8192, R, C); const int Rb = perm ? ((R & ~31) + perm32(R & 31)) : R; v[i] = (unsigned)(Rb * pitch + C) * 2u; }
}
__device__ __forceinline__ void head_voff(unsigned (&v)[2], int pitch) {
    int tz = threadIdx.x; asm volatile("" : "+v"(tz));
#pragma unroll
    for (int i = 0; i < 2; ++i) { int R, C; stage_rc(tz * 16 + i * 8192, R, C); const int Rb = 64 * ((R >> 5) & 3) + perm32(R & 31); v[i] = (unsigned)(Rb * pitch + C) * 2u; }
}
}

struct MkArgs { const float* in[25]; float* out; unsigned char* ws; int ph_lo, ph_hi, li, pad; };

struct P2Tiles { const char* A; const char* Bt; int G, c;
    __device__ __forceinline__ bool get(int i, pg::Tile& t) const { int pm, pn; if (!pg::static_unit(i, G, c, T / 256, NPROJ / 256, pm, pn)) return false;
        t.a0 = A + (size_t)pm * 256 * KP * 2; t.a1 = t.a0 + (size_t)128 * KP * 2; t.b0 = Bt + (size_t)pn * 256 * KP * 2; t.b1 = t.b0 + (size_t)32 * KP * 2; return true; } };
struct P2Epi { bf16_t* O; const float* gq; const float* gk; int G, c;
    __device__ __forceinline__ void operator()(const f32x4 (&acc)[2][2][4][2], int i, int wr, int wc, int fr, int fq) const {
        int pm, pn; pg::static_unit(i, G, c, T / 256, NPROJ / 256, pm, pn);
        const int colt = pn * 256, tsr = colt >> 9; bf16_t* base = O + (size_t)tsr * (PROJ_STRIDE / 2); const int col0 = (colt & 511) + wc * 64 + 8 * fq, row0 = pm * 256 + wr * 64 + fr;
        const bool nrm = (tsr == 2) || (tsr == 3);
        f32x4 gn[2][2];
        if (nrm) { const float* gp = (tsr == 2) ? gq : gk; const float sc = (tsr == 2) ? 0.125f * 1.4426950408889634f : 1.0f;
#pragma unroll
            for (int bj = 0; bj < 2; ++bj)
#pragma unroll
                for (int n = 0; n < 2; ++n) gn[bj][n] = *(const f32x4*)(gp + 32 * bj + 8 * fq + 4 * n) * sc; }
#pragma unroll
        for (int ai = 0; ai < 2; ++ai)
#pragma unroll
            for (int m = 0; m < 4; ++m) { bf16_t* rowp = base + (size_t)(row0 + ai * 128 + m * 16) * PP + col0;
                f32x4 v[2][2];
#pragma unroll
                for (int bj = 0; bj < 2; ++bj) { v[bj][0] = acc[ai][bj][m][0]; v[bj][1] = acc[ai][bj][m][1]; }
                if (nrm) { float ss = 0.f;
#pragma unroll
                    for (int bj = 0; bj < 2; ++bj)
#pragma unroll
                        for (int n = 0; n < 2; ++n) ss += v[bj][n].x * v[bj][n].x + v[bj][n].y * v[bj][n].y + v[bj][n].z * v[bj][n].z + v[bj][n].w * v[bj][n].w;
                    ss += __shfl_xor(ss, 16); ss += __shfl_xor(ss, 32);
                    const float ri = rsqrtf(ss * (1.0f / 64) + EPS);
#pragma unroll
                    for (int bj = 0; bj < 2; ++bj)
#pragma unroll
                        for (int n = 0; n < 2; ++n) v[bj][n] = v[bj][n] * ri * gn[bj][n]; }
#pragma unroll
                for (int bj = 0; bj < 2; ++bj) {
                    u32x4 w; w.x = pg::cvt_pk_bf16(v[bj][0][0], v[bj][0][1]); w.y = pg::cvt_pk_bf16(v[bj][0][2], v[bj][0][3]); w.z = pg::cvt_pk_bf16(v[bj][1][0], v[bj][1][1]); w.w = pg::cvt_pk_bf16(v[bj][1][2], v[bj][1][3]);
                    *(u32x4*)(rowp + bj * 32) = w; } }
    } };
struct P4Tiles { const char* A; const char* Bt; int G, c;
    __device__ __forceinline__ bool get(int i, pg::Tile& t) const { int pm, pn; if (!pg::static_unit(i, G, c, T / 256, D / 256, pm, pn)) return false;
        t.a0 = A + (size_t)pm * 256 * KP * 2; t.a1 = t.a0 + (size_t)128 * KP * 2; t.b0 = Bt + (size_t)pn * 256 * KP * 2; t.b1 = t.b0 + (size_t)128 * KP * 2; return true; } };
struct P4Epi { const float* mod; bf16_t* O; int G, c;
    __device__ __forceinline__ void operator()(const f32x4 (&acc)[2][2][4][2], int i, int wr, int wc, int fr, int fq) const {
        int pm, pn; pg::static_unit(i, G, c, T / 256, D / 256, pm, pn);
        const int row0 = pm * 256 + wr * 64 + fr, col0 = pn * 256 + wc * 32 + 8 * fq; const float* g1 = mod + (size_t)(pm >> 3) * 6144 + 2048;
        f32x4 gv[2][2];
#pragma unroll
        for (int bj = 0; bj < 2; ++bj)
#pragma unroll
            for (int n = 0; n < 2; ++n) gv[bj][n] = *(const f32x4*)(g1 + col0 + bj * 128 + n * 4);
#pragma unroll
        for (int ai = 0; ai < 2; ++ai)
#pragma unroll
            for (int m = 0; m < 4; ++m) { bf16_t* rowp = O + (size_t)(row0 + ai * 128 + m * 16) * D + col0;
#pragma unroll
                for (int bj = 0; bj < 2; ++bj) { const f32x4 v0 = acc[ai][bj][m][0] * gv[bj][0], v1 = acc[ai][bj][m][1] * gv[bj][1];
                    u32x4 w; w.x = pg::cvt_pk_bf16(v0[0], v0[1]); w.y = pg::cvt_pk_bf16(v0[2], v0[3]); w.z = pg::cvt_pk_bf16(v1[0], v1[1]); w.w = pg::cvt_pk_bf16(v1[2], v1[3]);
                    *(u32x4*)(rowp + bj * 128) = w; } }
    } };
struct F1Tiles { const char* A; const char* Wg; const char* Wu;
    __device__ __forceinline__ bool get(int i, pg::Tile& t) const { if (i >= 16) return false; t.a0 = A; t.a1 = A; t.b0 = Wg + (size_t)i * 128 * KP * 2; t.b1 = Wu + (size_t)i * 128 * KP * 2; return true; } };
struct F1Epi { bf16_t* hid;
    __device__ __forceinline__ void operator()(const f32x4 (&acc)[2][2][4][2], int i, int wr, int wc, int fr, int fq) const {
        const int row0 = wr * 64 + fr, col0 = i * 128 + wc * 32 + 8 * fq;
#pragma unroll
        for (int ai = 0; ai < 2; ++ai)
#pragma unroll
            for (int m = 0; m < 4; ++m) { float h[8];
#pragma unroll
                for (int n = 0; n < 2; ++n)
#pragma unroll
                    for (int j = 0; j < 4; ++j) { const float g = acc[ai][0][m][n][j], u = acc[ai][1][m][n][j]; h[n * 4 + j] = g * u * frcp(1.0f + fexp(-g)); }
                u32x4 w; w.x = pg::cvt_pk_bf16(h[0], h[1]); w.y = pg::cvt_pk_bf16(h[2], h[3]); w.z = pg::cvt_pk_bf16(h[4], h[5]); w.w = pg::cvt_pk_bf16(h[6], h[7]);
                *(u32x4*)(hid + (size_t)(row0 + ai * 128 + m * 16) * HIDP + col0) = w; }
    } };
struct F2Tiles { const char* hid; const char* Wd; int x, sl;
    __device__ __forceinline__ bool get(int i, pg::Tile& t) const { if (i >= 4) return false; const int e = 4 * i + (x >> 1), b = 8 * (x & 1) + (sl >> 2), pn = sl & 3, be = b * 16 + e;
        t.a0 = hid + (size_t)be * CAP * HIDP * 2; t.a1 = t.a0 + (size_t)128 * HIDP * 2; t.b0 = Wd + ((size_t)e * D + pn * 256) * HIDP * 2; t.b1 = t.b0 + (size_t)128 * HIDP * 2; return true; } };
struct F2Epi { bf16_t* Y; const float* gsel; int x, sl;
    __device__ __forceinline__ void operator()(const f32x4 (&acc)[2][2][4][2], int i, int wr, int wc, int fr, int fq) const {
        const int e = 4 * i + (x >> 1), b = 8 * (x & 1) + (sl >> 2), pn = sl & 3, be = b * 16 + e;
        const int row0 = wr * 64 + fr, col0 = pn * 256 + wc * 32 + 8 * fq;
        float gv[2][4];
#pragma unroll
        for (int ai = 0; ai < 2; ++ai)
#pragma unroll
            for (int m = 0; m < 4; ++m) gv[ai][m] = gsel[(size_t)be * CAP + row0 + ai * 128 + m * 16];
#pragma unroll
        for (int ai = 0; ai < 2; ++ai)
#pragma unroll
            for (int m = 0; m < 4; ++m) { const int r = row0 + ai * 128 + m * 16; bf16_t* rowp = Y + ((size_t)be * CAP + r) * D + col0;
#pragma unroll
                for (int bj = 0; bj < 2; ++bj) { const f32x4 v0 = acc[ai][bj][m][0] * gv[ai][m], v1 = acc[ai][bj][m][1] * gv[ai][m];
                    u32x4 w; w.x = pg::cvt_pk_bf16(v0[0], v0[1]); w.y = pg::cvt_pk_bf16(v0[2], v0[3]); w.z = pg::cvt_pk_bf16(v1[0], v1[1]); w.w = pg::cvt_pk_bf16(v1[2], v1[3]);
                    *(u32x4*)(rowp + bj * 128) = w; } }
    } };


struct TItem { const float* W; bf16_t* WT; int ldw, K, k0, src_n0, n0; };
__device__ __forceinline__ void titem_load(const TItem& t, f32x4 (&r)[8], int lane) {
#pragma unroll
    for (int i = 0; i < 8; ++i) { const int kk = 8 * i + (lane >> 3), n4 = (lane & 7) * 4; r[i] = __builtin_nontemporal_load((const f32x4*)(t.W + (size_t)(t.k0 + kk) * t.ldw + t.src_n0 + n4)); }
}
typedef short s16x4c __attribute__((ext_vector_type(4)));
__device__ __forceinline__ void titem_store(const TItem& t, const f32x4 (&r)[8], LAS unsigned char* scr, int lane) {
#pragma unroll
    for (int i = 0; i < 8; ++i) { const int kk = 8 * i + (lane >> 3); *(LAS u32x2*)(scr + kk * 96 + (lane & 7) * 8) = (u32x2){pk2(r[i].x, r[i].y), pk2(r[i].z, r[i].w)}; }
    asm volatile("" ::: "memory");
    const int fr = lane & 15, g = lane >> 4, q_ = fr >> 2, pp = fr & 3;
#pragma unroll
    for (int nb = 0; nb < 2; ++nb)
#pragma unroll
        for (int kh = 0; kh < 2; ++kh) { LAS unsigned char* p = scr + (32 * kh + 8 * g + q_) * 96 + nb * 32 + pp * 8;
            const s16x4c v0 = __builtin_amdgcn_ds_read_tr16_b64_v4i16((LAS s16x4c*)p), v1 = __builtin_amdgcn_ds_read_tr16_b64_v4i16((LAS s16x4c*)(p + 4 * 96));
            typedef short s16x8c __attribute__((ext_vector_type(8)));
            const s16x8c o = (s16x8c){v0[0], v0[1], v0[2], v0[3], v1[0], v1[1], v1[2], v1[3]};
            *(u32x4*)(t.WT + (size_t)(t.n0 + 16 * nb + fr) * t.K + t.k0 + 32 * kh + 8 * g) = __builtin_bit_cast(u32x4, o); }
    asm volatile("s_waitcnt lgkmcnt(0)" ::: "memory");
}
__device__ __forceinline__ TItem p0_item(const MkArgs& a, int it) {
    unsigned char* ws = a.ws; TItem t;
    constexpr int I_IN = 16 * 80, I_OUT = 16 * 32, I_GE = 16 * 64, I_DE = 32 * 32;
    int r = it;
    if (r < I_IN) { const int kb = r / 80, nb = r % 80, n0 = nb * 32; t.W = a.in[5]; t.ldw = PROJ_TOTAL; t.K = KP; t.k0 = kb * 64; t.src_n0 = n0 < 1024 ? n0 : n0 + 16; t.WT = (bf16_t*)(ws + WS_WIN); t.n0 = n0; return t; } r -= I_IN;
    if (r < I_OUT) { const int kb = r / 32, nb = r % 32; t.W = a.in[18]; t.ldw = D; t.K = KP; t.k0 = kb * 64; t.src_n0 = nb * 32; t.WT = (bf16_t*)(ws + WS_WOUT); t.n0 = nb * 32; return t; } r -= I_OUT;
    if (r < 16 * I_GE) { const int e = r / I_GE, q = r % I_GE, kb = q / 64, nb = q % 64; t.W = a.in[22] + (size_t)e * D * DFF; t.ldw = DFF; t.K = KP; t.k0 = kb * 64; t.src_n0 = nb * 32; t.WT = (bf16_t*)(ws + WS_WG) + (size_t)e * DFF * KP; t.n0 = nb * 32; return t; } r -= 16 * I_GE;
    if (r < 16 * I_GE) { const int e = r / I_GE, q = r % I_GE, kb = q / 64, nb = q % 64; t.W = a.in[23] + (size_t)e * D * DFF; t.ldw = DFF; t.K = KP; t.k0 = kb * 64; t.src_n0 = nb * 32; t.WT = (bf16_t*)(ws + WS_WU) + (size_t)e * DFF * KP; t.n0 = nb * 32; return t; } r -= 16 * I_GE;
    { const int e = r / I_DE, q = r % I_DE, kb = q / 32, nb = q % 32; t.W = a.in[24] + (size_t)e * DFF * D; t.ldw = D; t.K = HIDP; t.k0 = kb * 64; t.src_n0 = nb * 32; t.WT = (bf16_t*)(ws + WS_WD) + (size_t)e * D * HIDP; t.n0 = nb * 32; return t; }
}
__device__ __forceinline__ void p0_phase(const MkArgs& a, LAS unsigned char* lds, int G, int bx, int tid, int lane, int wave) {
    unsigned char* ws = a.ws;
    float* mod = (float*)(ws + WS_MOD);
    if (bx < 192) {
        const float* cc = a.in[1]; const float* w_ada = a.in[2]; const float* b_ada = a.in[3];
        LAS float* red = (LAS float*)lds;
        const int n0 = bx * 32, bq = lane & 15, ks = lane >> 4;
        f32x4 av[8]; float bv0[32], bv1[32];
        const float* cp = cc + bq * 1024 + 128 * wave + 32 * ks;
#pragma unroll
        for (int i = 0; i < 8; ++i) av[i] = *(const f32x4*)(cp + 4 * i);
        const float* wp = w_ada + (size_t)(128 * wave + 32 * ks) * 6144 + n0 + bq;
#pragma unroll
        for (int sidx = 0; sidx < 32; ++sidx) { bv0[sidx] = wp[(size_t)sidx * 6144]; bv1[sidx] = wp[(size_t)sidx * 6144 + 16]; }
        f32x4 acc0 = (f32x4){0.f, 0.f, 0.f, 0.f}, acc1 = (f32x4){0.f, 0.f, 0.f, 0.f};
#pragma unroll
        for (int sidx = 0; sidx < 32; ++sidx) { const float sv = silu_f(av[sidx >> 2][sidx & 3]);
            acc0 = __builtin_amdgcn_mfma_f32_16x16x4f32(sv, bv0[sidx], acc0, 0, 0, 0); acc1 = __builtin_amdgcn_mfma_f32_16x16x4f32(sv, bv1[sidx], acc1, 0, 0, 0); }
        *(LAS f32x4*)(red + ((wave * 2 + 0) * 64 + lane) * 4) = acc0; *(LAS f32x4*)(red + ((wave * 2 + 1) * 64 + lane) * 4) = acc1;
        __syncthreads();
        {   const int t = tid >> 8, l = (tid >> 2) & 63, r = tid & 3; float sum = 0.f;
#pragma unroll
            for (int w = 0; w < 8; ++w) sum += red[((w * 2 + t) * 64 + l) * 4 + r];
            const int n = n0 + 16 * t + (l & 15), bb = 4 * (l >> 4) + r; mod[bb * 6144 + n] = sum + b_ada[n]; }
    }
    if (bx == G - 1) {
        float* bt = (float*)(ws + WS_BIAS); const float* rel_bias = a.in[17];
        for (int i = tid; i < 3 * 8 * 129; i += 512) { const int p = i / (8 * 129), h = (i / 129) % 8, r = i % 129; const int dil = p == 0 ? 1 : (p == 1 ? 4 : 16);
            bt[(p * 8 + h) * 132 + r] = rel_bias[t5_bucket((r - 64) * dil) * 8 + h]; }
    }
}

__device__ __forceinline__ float reduce16(float (&v)[16], int lane) {
    float a8[8], a4[4], a2[2];
    const bool h5 = lane & 32, h4 = lane & 16, h3 = lane & 8, h2 = lane & 4;
#pragma unroll
    for (int i = 0; i < 8; ++i) { const float send = h5 ? v[i] : v[i + 8], keep = h5 ? v[i + 8] : v[i]; a8[i] = keep + __shfl_xor(send, 32); }
#pragma unroll
    for (int i = 0; i < 4; ++i) { const float send = h4 ? a8[i] : a8[i + 4], keep = h4 ? a8[i + 4] : a8[i]; a4[i] = keep + __shfl_xor(send, 16); }
#pragma unroll
    for (int i = 0; i < 2; ++i) { const float send = h3 ? a4[i] : a4[i + 2], keep = h3 ? a4[i + 2] : a4[i]; a2[i] = keep + __shfl_xor(send, 8); }
    float r; { const float send = h2 ? a2[0] : a2[1], keep = h2 ? a2[1] : a2[0]; r = keep + __shfl_xor(send, 4); }
    r += __shfl_xor(r, 1); r += __shfl_xor(r, 2);
    return r;
}
template <int MODE>
__device__ __forceinline__ void norm_phase(const MkArgs& a, LAS unsigned char* lds, int G, int bx, int tid, int lane, int wave) {
    unsigned char* ws = a.ws;
    constexpr int WP = 1028;
    LAS float* Wt = (LAS float*)lds; LAS float* mulL = Wt + 16 * WP; LAS float* addL = mulL + 1024; LAS float* cqL = addL + 1024; LAS float* red = cqL + 16; LAS float* exL = red + 512;
    const int b = (bx * 128) / S;
    const float* gvec = MODE == 0 ? a.in[4] : a.in[19];
    const float* mod = (const float*)(ws + WS_MOD) + b * 6144 + (MODE == 0 ? 0 : 3072);
    const float* xin = a.in[0]; const bf16_t* mixp = (const bf16_t*)(ws + WS_MIX);
    bf16_t* hB = (bf16_t*)(ws + WS_HB);
    int tz = threadIdx.x; asm volatile("" : "+v"(tz));
    tid = tz; lane = tz & 63; wave = __builtin_amdgcn_readfirstlane(tz >> 6);
    const int r = lane & 15, g = lane >> 4, qf = wave & 3, pr = wave >> 2;
    const int cb = 256 * qf + 16 * g;
    f32x4 xr[4][4]; u32x4 mr[4][2];
#define NP_LOAD(kb_, m_) do { const float* xp_ = xin + (size_t)(m_) * D + cb + 64 * (kb_); \
        xr[kb_][0] = *(const f32x4*)(xp_); xr[kb_][1] = *(const f32x4*)(xp_ + 4); xr[kb_][2] = *(const f32x4*)(xp_ + 8); xr[kb_][3] = *(const f32x4*)(xp_ + 12); \
        if (MODE == 1) { const bf16_t* mp_ = mixp + (size_t)(m_) * D + cb + 64 * (kb_); mr[kb_][0] = *(const u32x4*)(mp_); mr[kb_][1] = *(const u32x4*)(mp_ + 8); } } while (0)
    {   const int mf = (bx * 8 + pr) * 16 + r;
#pragma unroll
        for (int kb = 0; kb < 4; ++kb) NP_LOAD(kb, mf); }
    TItem wt_; f32x4 wreg_[8]; const bool wdo_ = MODE == 0 && (bx * 8 + wave) < 16 * 80 + 16 * 32;
    if (wdo_) { wt_ = p0_item(a, bx * 8 + wave); titem_load(wt_, wreg_, lane); }
    if (MODE == 0) { const float* w_in = a.in[5];
#pragma unroll 8
        for (int i = tid; i < 16 * 1024; i += 512) { const int k = i >> 4, q = i & 15; Wt[q * WP + k] = w_in[(size_t)k * PROJ_TOTAL + 1024 + q]; } }
    else { const float* w_r = a.in[20];
#pragma unroll 8
        for (int i = tid; i < 16 * 1024; i += 512) { const int k = i >> 4, q = i & 15; Wt[q * WP + k] = w_r[i]; } }
    for (int k = tid; k < 1024; k += 512) { mulL[k] = gvec[k] * (1.0f + mod[1024 + k]); addL[k] = mod[k]; }
    __syncthreads();
    { const int q = tid & 15, part = tid >> 4; float sacc = 0.f;
      for (int k = part * 32; k < part * 32 + 32; ++k) sacc += addL[k] * Wt[q * WP + k];
      red[part * 16 + q] = sacc; }
    __syncthreads();
    if (tid < 16) { float sacc = 0.f; for (int p = 0; p < 32; ++p) sacc += red[p * 16 + tid]; cqL[tid] = sacc; }
    __syncthreads();
#pragma unroll 1
    for (int rd = 0; rd < 4; ++rd) {
        const int m0 = (bx * 8 + pr + 2 * rd) * 16, m = m0 + r;
        if (MODE == 1) {
#pragma unroll
            for (int kb = 0; kb < 4; ++kb) {
#pragma unroll
                for (int hh = 0; hh < 2; ++hh) { const u32x4 mm = mr[kb][hh];
                    xr[kb][2 * hh].x += __uint_as_float(mm.x << 16); xr[kb][2 * hh].y += __uint_as_float(mm.x & 0xffff0000u); xr[kb][2 * hh].z += __uint_as_float(mm.y << 16); xr[kb][2 * hh].w += __uint_as_float(mm.y & 0xffff0000u);
                    xr[kb][2 * hh + 1].x += __uint_as_float(mm.z << 16); xr[kb][2 * hh + 1].y += __uint_as_float(mm.z & 0xffff0000u); xr[kb][2 * hh + 1].z += __uint_as_float(mm.w << 16); xr[kb][2 * hh + 1].w += __uint_as_float(mm.w & 0xffff0000u); }
#pragma unroll
                for (int j = 0; j < 4; ++j) *(f32x4*)(a.out + (size_t)m * D + cb + 64 * kb + 4 * j) = xr[kb][j];
            }
        }
        f32x4 acc = (f32x4){0.f, 0.f, 0.f, 0.f}; float ss = 0.f;
#pragma unroll
        for (int kb = 0; kb < 4; ++kb) {
            asm volatile("" ::: "memory");
            const int kc = cb + 64 * kb;
#pragma unroll
            for (int j = 0; j < 4; ++j) { const f32x4 mu = *(const LAS f32x4*)(mulL + kc + 4 * j), wv = *(const LAS f32x4*)(Wt + r * WP + kc + 4 * j);
#pragma unroll
                for (int i = 0; i < 4; ++i) { const float xx = xr[kb][j][i]; ss += xx * xx; acc = __builtin_amdgcn_mfma_f32_16x16x4f32(xx * mu[i], wv[i], acc, 0, 0, 0); } }
        }
        ss += __shfl_xor(ss, 16); ss += __shfl_xor(ss, 32);
        {   LAS float* exw = exL + (((rd & 1) * 8 + wave) * 64 + lane) * 5; exw[0] = ss; exw[1] = acc[0]; exw[2] = acc[1]; exw[3] = acc[2]; exw[4] = acc[3]; }
        __syncthreads();
        float val;
        {   const LAS float* exr = exL + (((rd & 1) * 8 + 4 * pr) * 64 + lane) * 5;
            ss = (exr[0] + exr[320]) + (exr[640] + exr[960]);
            val = (exr[1 + qf] + exr[320 + 1 + qf]) + (exr[640 + 1 + qf] + exr[960 + 1 + qf]); }
        const float rinv = rsqrtf(ss * (1.0f / D) + EPS);
        val = val * __shfl(rinv, 4 * g + qf) + cqL[r];
        if (MODE == 0) {
            const float* b_ig = a.in[11]; const float* b_fg = a.in[12];
            const int grp = r >> 2, hh = r & 3; float o;
            if (grp == 0) o = val + b_ig[hh]; else if (grp == 1) o = log_sigmoid_f(val + b_fg[hh]); else if (grp == 2) o = val + b_ig[4 + hh]; else o = log_sigmoid_f(val + b_fg[4 + hh]);
            ((float*)(ws + WS_GATES))[(size_t)(m0 + 4 * g + qf) * 16 + r] = o;
        } else {
            const float lg = val + a.in[21][r]; float mx = lg;
#pragma unroll
            for (int o = 1; o < 16; o <<= 1) mx = fmaxf(mx, __shfl_xor(mx, o));
            const float ex = expf(lg - mx); float sum = ex;
#pragma unroll
            for (int o = 1; o < 16; o <<= 1) sum += __shfl_xor(sum, o);
            const int mm = m0 + 4 * g + qf;
            ((float*)(ws + WS_AFF))[(size_t)((mm >> 11) * 16 + r) * S + (mm & 2047)] = ex / sum;
        }
        bf16_t* hrow = hB + (size_t)m * KP + cb;
#pragma unroll
        for (int kb = 0; kb < 4; ++kb) { const int kc = cb + 64 * kb; unsigned w[8];
            asm volatile("" ::: "memory");
#pragma unroll
            for (int j = 0; j < 4; ++j) { const f32x4 xx = xr[kb][j], mu = *(const LAS f32x4*)(mulL + kc + 4 * j), ad = *(const LAS f32x4*)(addL + kc + 4 * j);
                w[2 * j] = pk2(xx.x * rinv * mu.x + ad.x, xx.y * rinv * mu.y + ad.y); w[2 * j + 1] = pk2(xx.z * rinv * mu.z + ad.z, xx.w * rinv * mu.w + ad.w); }
            *(u32x4*)(hrow + 64 * kb) = (u32x4){w[0], w[1], w[2], w[3]}; *(u32x4*)(hrow + 64 * kb + 8) = (u32x4){w[4], w[5], w[6], w[7]};
            if (rd < 3) NP_LOAD(kb, m + 32); }
    }
    if (wdo_) titem_store(wt_, wreg_, lds + 110592 + wave * 6144, lane);
#undef NP_LOAD
}
__device__ __forceinline__ void topk_sort(const float* aff, LAS unsigned long long* keys, LAS int* idxs, LAS float* gsl, float* gselg, unsigned short* inv, int tid) {
#pragma unroll
    for (int i = 0; i < 4; ++i) { const int s = tid + 512 * i; keys[s] = ((unsigned long long)__float_as_uint(aff[s]) << 32) | (unsigned)(2047 - s); }
    __syncthreads();
    for (int k = 2; k <= 2048; k <<= 1)
        for (int j = k >> 1; j > 0; j >>= 1) {
#pragma unroll
            for (int pp = 0; pp < 2; ++pp) { const int p = tid + 512 * pp; const int i1 = ((p & ~(j - 1)) << 1) | (p & (j - 1)), i2 = i1 | j;
                const unsigned long long x1 = keys[i1], x2 = keys[i2]; const bool desc = (i1 & k) == 0;
                if ((x1 < x2) == desc) { keys[i1] = x2; keys[i2] = x1; } }
            __syncthreads();
        }
    if (tid < 256) { const unsigned long long kk = keys[tid]; idxs[tid] = 2047 - (int)(unsigned)(kk & 0xffffffffu); gsl[tid] = __uint_as_float((unsigned)(kk >> 32)); gselg[tid] = __uint_as_float((unsigned)(kk >> 32)); }
#pragma unroll
    for (int i = 0; i < 4; ++i) { const int p = tid + 512 * i; inv[2047 - (int)(unsigned)(keys[p] & 0xffffffffu)] = (unsigned short)(p < 256 ? p : 0xFFFF); }
    __syncthreads();
}


typedef short s16x4 __attribute__((ext_vector_type(4)));
constexpr float LOG2E = 1.4426950408889634f;
__device__ __forceinline__ int att_stage_token(int dsu, int i) {
    const int p = dsu >> 3, k = dsu & 7;
    if (p == 0) { int pos = 256 * k - 64 + i; pos = pos < 0 ? 0 : (pos > 2047 ? 2047 : pos); return pos; }
    if (p == 1) { int pos = 256 * (k & 1) - 64 + i; pos = pos < 0 ? 0 : (pos > 511 ? 511 : pos); return pos * 4 + (k >> 1); }
    return (i & 127) * 16 + 2 * k + (i >> 7);
}
struct AttTile { int p, dil, L, r_w, pq0, pos_lo, rowbase; };
__device__ __forceinline__ AttTile att_tile(int dsu, int j, int wave) {
    const int p = dsu >> 3, k = dsu & 7; AttTile t; t.p = p;
    if (p == 0) { t.dil = 1; t.L = 2048; t.r_w = 0; t.pos_lo = 256 * k - 64; t.pq0 = 256 * k + 128 * j + 16 * wave; t.rowbase = 0; }
    else if (p == 1) { t.dil = 4; t.L = 512; t.r_w = k >> 1; t.pos_lo = 256 * (k & 1) - 64; t.pq0 = 256 * (k & 1) + 128 * j + 16 * wave; t.rowbase = 0; }
    else { t.dil = 16; t.L = 128; t.r_w = 2 * k + (wave >> 2); t.pos_lo = 0; t.pq0 = 64 * j + 16 * (wave & 3); t.rowbase = (wave >> 2) * 128; }
    return t;
}
__device__ __forceinline__ void att_issue_q(const bf16_t* AQ, int dsu, int lane, int wave, u32x4 (&qreg)[4]) {
    const int g = lane >> 4;
#pragma unroll
    for (int j = 0; j < 2; ++j) { const AttTile t = att_tile(dsu, j, wave); const int tokq = (t.pq0 + (lane & 15)) * t.dil + t.r_w;
        qreg[2 * j] = *(const u32x4*)(AQ + (size_t)tokq * PP + 8 * g); qreg[2 * j + 1] = *(const u32x4*)(AQ + (size_t)tokq * PP + 32 + 8 * g); }
}
__device__ __forceinline__ void att_issue(const bf16_t* AK, const bf16_t* AV, int dsu, int tid, u32x4 (&kreg)[6], u32x4 (&vreg)[6]) {
    const int c = tid & 7;
    const int nk = (dsu >> 3) == 2 ? 4 : 6;
#pragma unroll
    for (int k = 0; k < 6; ++k) if (k < nk) { const int i = (tid >> 3) + 64 * k; const size_t off = (size_t)att_stage_token(dsu, i) * PP + 8 * c;
        kreg[k] = *(const u32x4*)(AK + off); vreg[k] = *(const u32x4*)(AV + off); }
}
__device__ __forceinline__ void att_write(LAS unsigned char* Ks, LAS unsigned char* Vs, int dsu, int tid, const u32x4 (&kreg)[6], const u32x4 (&vreg)[6]) {
    const int c = tid & 7; const int nk = (dsu >> 3) == 2 ? 4 : 6;
#pragma unroll
    for (int k = 0; k < 6; ++k) if (k < nk) { const int i = (tid >> 3) + 64 * k;
        *(LAS u32x4*)(Ks + i * 128 + ((c ^ (i & 7)) << 4)) = kreg[k];
        *(LAS u32x4*)(Vs + i * 128 + ((((c >> 1) ^ ((i >> 1) & 3))) << 5) + ((c & 1) << 4)) = vreg[k]; }
}
__device__ __forceinline__ void att_compute(const u32x4 (&qreg)[2], bf16_t* YA, float* LSE, LAS unsigned char* Ks, LAS unsigned char* Vs, const LAS float* biasL, const AttTile tl, int lane) {
    const int p = tl.p, fr = lane & 15, g = lane >> 4;
    const int dil = tl.dil, L = tl.L, r_w = tl.r_w, pq0 = tl.pq0, pos_lo = tl.pos_lo, rowbase = tl.rowbase;
    const int tokq = (pq0 + fr) * dil + r_w;
    bf16x8 qf[2];
    bf16_t* yrow = YA + (size_t)tokq * KP + 4 * g; float* lp = LSE + (size_t)tokq * 8;
    float lprev = 0.f; unsigned long long pvv[4] = {0ull, 0ull, 0ull, 0ull};
    if (p > 0) { lprev = __hip_atomic_load(lp, __ATOMIC_RELAXED, __HIP_MEMORY_SCOPE_AGENT);
#pragma unroll
        for (int dt = 0; dt < 4; ++dt) pvv[dt] = __hip_atomic_load((unsigned long long*)(yrow + 16 * dt), __ATOMIC_RELAXED, __HIP_MEMORY_SCOPE_AGENT); }
    qf[0] = __builtin_bit_cast(bf16x8, qreg[0]); qf[1] = __builtin_bit_cast(bf16x8, qreg[1]);
    f32x4 st[9]; int trow[10]; bool tval[9];
#pragma unroll
    for (int n = 0; n < 9; ++n) { const int pos_n = pq0 - 64 + 16 * n; tval[n] = (pos_n >= 0) && (pos_n < L); trow[n] = rowbase + (tval[n] ? pos_n - pos_lo : 0); }
    trow[9] = trow[8];
#pragma unroll
    for (int n = 0; n < 9; ++n) { const int row = trow[n] + fr;
        const bf16x8 a0 = *(const LAS bf16x8*)(Ks + row * 128 + ((g ^ (row & 7)) << 4)), a1 = *(const LAS bf16x8*)(Ks + row * 128 + (((4 + g) ^ (row & 7)) << 4));
        f32x4 z = (f32x4){0.f, 0.f, 0.f, 0.f};
        z = __builtin_amdgcn_mfma_f32_16x16x32_bf16(a0, qf[0], z, 0, 0, 0);
        st[n] = __builtin_amdgcn_mfma_f32_16x16x32_bf16(a1, qf[1], z, 0, 0, 0); }
    const LAS float* bl = biasL + p * 160 + 16;
    float lsum = 0.f;
#pragma unroll
    for (int n = 0; n < 9; ++n)
#pragma unroll
        for (int r = 0; r < 4; ++r) { const float e = fexp2(st[n][r] + bl[16 * n + 4 * g + r - fr]); st[n][r] = tval[n] ? e : 0.f; lsum += st[n][r]; }
    lsum += __shfl_xor(lsum, 16); lsum += __shfl_xor(lsum, 32);
    bf16x8 pf[5];
#pragma unroll
    for (int s2 = 0; s2 < 5; ++s2) { u32x4 w; w.x = pk2(st[2 * s2][0], st[2 * s2][1]); w.y = pk2(st[2 * s2][2], st[2 * s2][3]);
        if (s2 < 4) { w.z = pk2(st[2 * s2 + 1][0], st[2 * s2 + 1][1]); w.w = pk2(st[2 * s2 + 1][2], st[2 * s2 + 1][3]); } else { w.z = 0u; w.w = 0u; }
        pf[s2] = __builtin_bit_cast(bf16x8, w); }
    f32x4 oacc[4];
    const int q_ = fr >> 2, pp = fr & 3;
#pragma unroll
    for (int dt = 0; dt < 4; ++dt) { oacc[dt] = (f32x4){0.f, 0.f, 0.f, 0.f};
#pragma unroll
        for (int s2 = 0; s2 < 5; ++s2) { const int r0 = trow[2 * s2] + 4 * g + q_, r1 = trow[2 * s2 + 1] + 4 * g + q_;
            const s16x4 v0 = __builtin_amdgcn_ds_read_tr16_b64_v4i16((LAS s16x4*)(Vs + r0 * 128 + ((dt ^ ((r0 >> 1) & 3)) << 5) + 8 * pp));
            const s16x4 v1 = __builtin_amdgcn_ds_read_tr16_b64_v4i16((LAS s16x4*)(Vs + r1 * 128 + ((dt ^ ((r1 >> 1) & 3)) << 5) + 8 * pp));
            const bf16x8 va = (bf16x8){v0[0], v0[1], v0[2], v0[3], v1[0], v1[1], v1[2], v1[3]};
            oacc[dt] = __builtin_amdgcn_mfma_f32_16x16x32_bf16(va, pf[s2], oacc[dt], 0, 0, 0); } }
    if (p > 0) lsum += lprev;
    const float sc_ = (p == 2) ? frcp(lsum) : 1.0f;
#pragma unroll
    for (int dt = 0; dt < 4; ++dt) { float o[4];
#pragma unroll
        for (int r = 0; r < 4; ++r) o[r] = oacc[dt][r];
        if (p > 0) { const unsigned long long pv = pvv[dt]; const unsigned lo = (unsigned)pv, hi = (unsigned)(pv >> 32);
            o[0] += __uint_as_float(lo << 16); o[1] += __uint_as_float(lo & 0xffff0000u); o[2] += __uint_as_float(hi << 16); o[3] += __uint_as_float(hi & 0xffff0000u); }
        *(uint2*)(yrow + 16 * dt) = make_uint2(pk2(o[0] * sc_, o[1] * sc_), pk2(o[2] * sc_, o[3] * sc_)); }
    if (g == 0 && p < 2) *lp = lsum;
}
__device__ __forceinline__ void attn_unit(const MkArgs& a, LAS unsigned char* lds, int u, int aw, int tid, int lane, int wave) {
    unsigned char* ws = a.ws;
    const int b = u >> 3, hd = u & 7;
    const bf16_t* AQ = (const bf16_t*)(ws + WS_AQ) + (size_t)b * S * PP + hd * 64; const bf16_t* AK = (const bf16_t*)(ws + WS_AK) + (size_t)b * S * PP + hd * 64; const bf16_t* AV = (const bf16_t*)(ws + WS_AV) + (size_t)b * S * PP + hd * 64;
    bf16_t* YA = (bf16_t*)(ws + WS_YCAT) + (size_t)b * S * KP + 512 + hd * 64; float* LSE = (float*)(ws + WS_LSE) + (size_t)b * S * 8 + hd;
    LAS unsigned char* Ks = lds; LAS unsigned char* Vs = lds + 49152; LAS float* biasL = (LAS float*)(lds + 98304);
    const float* bt = (const float*)(ws + WS_BIAS);
    float shift;
    { float gqm = 0.f, gkm = 0.f, bm = 0.f;
      for (int d = 0; d < 64; ++d) { gqm = fmaxf(gqm, fabsf(a.in[15][d])); gkm = fmaxf(gkm, fabsf(a.in[16][d])); }
      for (int k = 0; k < 32; ++k) bm = fmaxf(bm, fabsf(a.in[17][k * 8 + hd]));
      shift = LOG2E * (8.0f * gqm * gkm + bm); }
    for (int i = tid; i < 3 * 160; i += 512) { const int p = i / 160, r = i % 160 - 16; biasL[i] = (r >= 0 && r <= 128) ? bt[(p * 8 + hd) * 132 + r] * LOG2E - shift : -INFINITY; }
    u32x4 kreg[6], vreg[6], qreg[4];
    LAS unsigned char* cscr = lds + 100352 + wave * 6144;
    att_issue(AK, AV, 0, tid, kreg, vreg); att_issue_q(AQ, 0, lane, wave, qreg);
    for (int dsu = 0; dsu < 24; ++dsu) {
        att_write(Ks, Vs, dsu, tid, kreg, vreg);
        __syncthreads();
        if (dsu + 1 < 24) att_issue(AK, AV, dsu + 1, tid, kreg, vreg);
        { TItem ct; f32x4 creg[8];
          ct = p0_item(a, 16 * 80 + 16 * 32 + aw + 1024 * dsu); titem_load(ct, creg, lane);
          const u32x4 q01[2] = {qreg[0], qreg[1]};
          att_compute(q01, YA, LSE, Ks, Vs, biasL, att_tile(dsu, 0, wave), lane);
          titem_store(ct, creg, cscr, lane); }
        { TItem ct; f32x4 creg[8]; const bool cdo = dsu < 18;
          if (cdo) { ct = p0_item(a, 16 * 80 + 16 * 32 + (dsu < 12 ? 36864 + 1024 * dsu : 30720 + 1024 * (dsu - 12)) + aw); titem_load(ct, creg, lane); }
          const u32x4 q23[2] = {qreg[2], qreg[3]};
          att_compute(q23, YA, LSE, Ks, Vs, biasL, att_tile(dsu, 1, wave), lane);
          if (cdo) titem_store(ct, creg, cscr, lane); }
        if (dsu + 1 < 24) att_issue_q(AQ, dsu + 1, lane, wave, qreg);
        asm volatile("s_waitcnt vmcnt(0)" ::: "memory");
        __syncthreads();
    }
}

__device__ __forceinline__ int swz256(int row, int ch) { return 256 * row + 16 * (ch ^ (((row & 3) << 2) | ((row >> 2) & 3))); }
constexpr int ML_XC = 0, ML_QP = 16384, ML_VV = 32768, ML_PM = 49152, ML_SC = 57344;
__device__ __forceinline__ void mlstm_unit(const MkArgs& a, LAS unsigned char* lds, int u, int tid, int lane, int wave) {
    unsigned char* ws = a.ws;
    const int b = u >> 3, h = (u >> 1) & 3, dir = u & 1;
    const bf16_t* XM = (const bf16_t*)(ws + WS_XM) + (size_t)b * S * PP + h * 128;
    const bf16_t* OP = (const bf16_t*)(ws + WS_OPRE) + (size_t)b * S * PP + h * 128;
    const float* gates = (const float*)(ws + WS_GATES) + (size_t)b * S * 16;
    unsigned char* HFmine = (dir ? (unsigned char*)a.out : (unsigned char*)(ws + WS_HB)) + (size_t)(u >> 1) * (512 * 1024);
    unsigned char* HFpart = (dir ? (unsigned char*)(ws + WS_HB) : (unsigned char*)a.out) + (size_t)(u >> 1) * (512 * 1024);
    const __amdgpu_buffer_rsrc_t rs_mine = __builtin_amdgcn_make_buffer_rsrc(HFmine, 0, 512 * 1024, 0x00020000);
    const __amdgpu_buffer_rsrc_t rs_part = __builtin_amdgcn_make_buffer_rsrc(HFpart, 0, 512 * 1024, 0x00020000);
    unsigned* prog_mine = (unsigned*)(ws + WS_CTL) + 131072 + 64 * u; unsigned* prog_part = (unsigned*)(ws + WS_CTL) + 131072 + 64 * (u ^ 1);
    bf16_t* YM = (bf16_t*)(ws + WS_YCAT) + (size_t)b * S * KP + h * 128;
    LAS float* sc = (LAS float*)(lds + ML_SC);
    LAS float* cL = sc, *mmL = sc + 64, *emtL = sc + 128, *wiL = sc + 192, *wL = sc + 256, *rs = sc + 320, *qnL = sc + 576, *nL = sc + 640, *nred = sc + 768, *ssq = sc + 1792, *misc = sc + 2304;
#define ML_LANES() int lz_ = lane; asm volatile("" : "+v"(lz_)); const int fr = lz_ & 15, g = lz_ >> 4, q_ = fr >> 2, pp = fr & 3; (void)q_; (void)pp; (void)g; (void)fr
    LAS float* constL = sc + 2432;
    if (tid < 32) { const int cgi = h * 128 + 4 * tid, ggi = cgi >> 2; LAS float* cd = constL + tid * 56;
      const float* conv_w = a.in[6]; const float* conv_b = a.in[7]; const float* wq = a.in[8] + ggi * 16; const float* wk = a.in[9] + ggi * 16; const float* wv = a.in[10] + ggi * 16;
      for (int i = 0; i < 4; ++i) { cd[20 + i] = conv_b[cgi + i];
          for (int w = 0; w < 5; ++w) cd[w * 4 + i] = conv_w[w * 512 + cgi + i];
          for (int ip = 0; ip < 4; ++ip) { float mm = 0.f;
              for (int j = 0; j < 4; ++j) mm += wq[i * 4 + j] * wk[ip * 4 + j];
              cd[24 + i * 4 + ip] = mm * 0.08838834764831845f; cd[40 + i * 4 + ip] = wv[i * 4 + ip]; } } }
    const float ng = a.in[13][h * 128 + 16 * wave + (lane & 15)], sk = a.in[14][h * 128 + 16 * wave + (lane & 15)];
    LAS float* gB = (LAS float*)(lds + 81920); LAS float* gC = gB + 2048; LAS float* gP = gC + 2048; LAS float* gS = gP + 2048;
    for (int ci = wave; ci < 32; ci += 8) { const int cch = dir ? 31 - ci : ci, tok = cch * 64 + (dir ? 63 - lane : lane);
        const float ig = gates[(size_t)tok * 16 + (dir ? 8 : 0) + h], lf = gates[(size_t)tok * 16 + (dir ? 12 : 4) + h];
        float bb = lf;
#pragma unroll
        for (int o = 1; o < 64; o <<= 1) { const float v = __shfl_up(bb, o); if (lane >= o) bb += v; }
        const float cc = ig - bb; float pm = cc;
#pragma unroll
        for (int o = 1; o < 64; o <<= 1) { const float v = __shfl_up(pm, o); if (lane >= o) pm = fmaxf(pm, v); }
        gB[ci * 64 + lane] = bb; gC[ci * 64 + lane] = cc; gP[ci * 64 + lane] = pm;
        if (lane == 63) { gS[2 * ci] = bb; gS[2 * ci + 1] = pm; } }
    u32x2 xmr[8];
#define ML_PREFETCH(cc) do { int tz_ = tid; asm volatile("" : "+v"(tz_)); const int g4p = tz_ & 31, tqp = tz_ >> 5; const int tbp = (cc) * 64; \
        _Pragma("unroll") for (int r = 0; r < 8; ++r) { const int tk = tbp + 4 * tqp - 2 + r; u32x2 w2 = (u32x2){0u, 0u}; if (tk >= 0 && tk < S) w2 = *(const u32x2*)(XM + (size_t)tk * PP + 4 * g4p); xmr[r] = w2; } \
        } while (0)
    {
        ML_PREFETCH(dir ? 31 : 0);
        f32x4 Cacc[8];
#pragma unroll
        for (int dt = 0; dt < 8; ++dt) Cacc[dt] = (f32x4){0.f, 0.f, 0.f, 0.f};
        for (int i = tid; i < 2048; i += 512) ((LAS unsigned*)(lds + ML_PM))[i] = 0u;
        if (tid < 256) rs[tid] = 0.f;
        if (tid < 128) nL[tid] = 0.f;
        if (tid == 0) { misc[0] = 0.f; misc[1] = 1.f; }
        __syncthreads();
        for (int ci = 0; ci < 32; ++ci) {
            const int c = dir ? 31 - ci : ci, tb = c * 64;
            TItem ct; f32x4 creg[8]; const bool cdo = ci < 6;
            if (cdo) ct = p0_item(a, 16 * 80 + 16 * 32 + 24576 + (u * 8 + wave) + 1024 * ci);
            { int tz_ = tid; asm volatile("" : "+v"(tz_)); const int g4 = tz_ & 31, tq = tz_ >> 5;
              float xm[8][4]; float cw[5][4], cb[4], Mq[4][4], Wv[4][4];
              { const LAS f32x4* cd = (const LAS f32x4*)(constL + g4 * 56);
#pragma unroll
                for (int w = 0; w < 5; ++w) { const f32x4 t4 = cd[w]; cw[w][0] = t4.x; cw[w][1] = t4.y; cw[w][2] = t4.z; cw[w][3] = t4.w; }
                { const f32x4 t4 = cd[5]; cb[0] = t4.x; cb[1] = t4.y; cb[2] = t4.z; cb[3] = t4.w; }
#pragma unroll
                for (int i = 0; i < 4; ++i) { const f32x4 t4 = cd[6 + i], t5 = cd[10 + i]; Mq[i][0] = t4.x; Mq[i][1] = t4.y; Mq[i][2] = t4.z; Mq[i][3] = t4.w; Wv[i][0] = t5.x; Wv[i][1] = t5.y; Wv[i][2] = t5.z; Wv[i][3] = t5.w; } }
#pragma unroll
              for (int r = 0; r < 8; ++r) { const u32x2 wv2 = xmr[r];
                  xm[r][0] = __uint_as_float(wv2.x << 16); xm[r][1] = __uint_as_float(wv2.x & 0xffff0000u); xm[r][2] = __uint_as_float(wv2.y << 16); xm[r][3] = __uint_as_float(wv2.y & 0xffff0000u); }
#pragma unroll
              for (int tl = 0; tl < 4; ++tl) { float xc[4];
#pragma unroll
                  for (int i = 0; i < 4; ++i) { float acc = cb[i];
#pragma unroll
                      for (int w = 0; w < 5; ++w) acc += cw[w][i] * xm[tl + w][i];
                      xc[i] = acc * frcp(1.0f + fexp(-acc)); }
                  float qv[4], vv[4];
#pragma unroll
                  for (int ip = 0; ip < 4; ++ip) { qv[ip] = xc[0] * Mq[0][ip] + xc[1] * Mq[1][ip] + xc[2] * Mq[2][ip] + xc[3] * Mq[3][ip];
                      vv[ip] = xm[tl + 2][0] * Wv[0][ip] + xm[tl + 2][1] * Wv[1][ip] + xm[tl + 2][2] * Wv[2][ip] + xm[tl + 2][3] * Wv[3][ip]; }
                  const int tloc = 4 * tq + tl, row = dir ? 63 - tloc : tloc; const int off = swz256(row, g4 >> 1) + 8 * (g4 & 1);
                  *(LAS u32x2*)(lds + ML_XC + off) = (u32x2){pk2(xc[0], xc[1]), pk2(xc[2], xc[3])};
                  *(LAS u32x2*)(lds + ML_QP + off) = (u32x2){pk2(qv[0], qv[1]), pk2(qv[2], qv[3])};
                  *(LAS u32x2*)(lds + ML_VV + off) = (u32x2){pk2(vv[0], vv[1]), pk2(vv[2], vv[3])}; } }
            if (wave == 0) {
                const float cc = gC[ci * 64 + lane], pm = gP[ci * 64 + lane], bb = gB[ci * 64 + lane], gtot = gS[2 * ci], amax = gtot + gS[2 * ci + 1];
                const float mprev = misc[0]; const float mnew = fmaxf(gtot + mprev, amax), mm = fmaxf(mprev, pm);
                cL[lane] = cc; mmL[lane] = mm; emtL[lane] = fexp(-(bb + mm)); wiL[lane] = fexp(mprev - mm); wL[lane] = fexp(gtot + cc - mnew);
                if (lane == 0) { misc[2] = mnew; misc[1] = fexp(gtot + mprev - mnew); }
            }
            if (ci >= 1 && ci <= 16) {
                asm volatile("s_waitcnt vmcnt(0)" ::: "memory");
                if (lane == 0) __hip_atomic_store(prog_mine + wave, (unsigned)ci, __ATOMIC_RELAXED, __HIP_MEMORY_SCOPE_AGENT); }
            if (cdo) titem_load(ct, creg, lane);
            if (ci + 1 < 32) ML_PREFETCH(dir ? 30 - ci : ci + 1);
            if (ci >= 16 && lane == 0) {
                const unsigned need = 32u - (unsigned)ci; unsigned spins = 0;
                while (__hip_atomic_load(prog_part + wave, __ATOMIC_RELAXED, __HIP_MEMORY_SCOPE_AGENT) < need) { __builtin_amdgcn_s_sleep(2); if (++spins > (1u << 22)) break; } }
            __syncthreads();
            float hfr[16], opr[16];
            if (ci >= 16) { ML_LANES();
#pragma unroll
                for (int tt = 0; tt < 4; ++tt)
#pragma unroll
                    for (int r = 0; r < 4; ++r) { const int tau = 16 * tt + 4 * g + r, tok = tb + (dir ? 63 - tau : tau); opr[tt * 4 + r] = bf2f(OP[(size_t)tok * PP + 16 * wave + fr]); }
            }
            {
                ML_LANES();
#pragma unroll
                for (int tt = 0; tt < 4; ++tt) { const unsigned off = (unsigned)((((((31 - ci) & 15) * 8 + wave) * 4 + (3 - tt)) * 64 + fr + 16 * (3 - g)) * 16);
                    const u32x4 hv = __builtin_amdgcn_raw_buffer_load_b128(rs_part, off, 0, 16);
                    hfr[tt * 4 + 0] = __uint_as_float(hv.w); hfr[tt * 4 + 1] = __uint_as_float(hv.z); hfr[tt * 4 + 2] = __uint_as_float(hv.y); hfr[tt * 4 + 3] = __uint_as_float(hv.x); } }
            { ML_LANES(); const int tt = wave & 3;
#pragma unroll
              for (int jj = 0; jj < 2; ++jj) { const int jt = 2 * (wave >> 2) + jj;
                  if (jt <= tt) { f32x4 z = (f32x4){0.f, 0.f, 0.f, 0.f};
                      const int rj = 16 * jt + fr, rt = 16 * tt + fr;
                      const int xf = ((fr & 3) << 2) | ((fr >> 2) & 3), cb_ = 256 * fr + 16 * (g ^ (xf & 3));
#pragma unroll
                      for (int s4 = 0; s4 < 4; ++s4) { const int co = cb_ + ((s4 ^ (xf >> 2)) << 6);
                          const bf16x8 av = *(const LAS bf16x8*)(lds + ML_XC + 4096 * jt + co), bv = *(const LAS bf16x8*)(lds + ML_QP + 4096 * tt + co);
                          z = __builtin_amdgcn_mfma_f32_16x16x32_bf16(av, bv, z, 0, 0, 0); }
                      const float mmt = mmL[rt]; float pv[4], psum = 0.f;
#pragma unroll
                      for (int r = 0; r < 4; ++r) { const int j = 16 * jt + 4 * g + r; const float e = (j <= rt) ? fexp(cL[j] - mmt) * z[r] : 0.f; pv[r] = e; psum += e; }
                      psum += __shfl_xor(psum, 16); psum += __shfl_xor(psum, 32);
                      if (g == 0) rs[jt * 64 + rt] = psum;
                      *(LAS u32x2*)(lds + ML_PM + rt * 128 + (((2 * jt + (g >> 1)) ^ (rt & 7)) << 4) + 8 * (g & 1)) = (u32x2){pk2(pv[0], pv[1]), pk2(pv[2], pv[3])}; } } }
            { int tz_ = tid; asm volatile("" : "+v"(tz_)); const int t = tz_ >> 3, part = tz_ & 7; float accq = 0.f;
#pragma unroll
              for (int hh = 0; hh < 2; ++hh) { const u32x4 qv = *(const LAS u32x4*)(lds + ML_QP + swz256(t, 2 * part + hh)); const f32x4 n0 = *(const LAS f32x4*)(nL + 16 * part + 8 * hh), n1 = *(const LAS f32x4*)(nL + 16 * part + 8 * hh + 4);
                  accq += __uint_as_float(qv.x << 16) * n0.x + __uint_as_float(qv.x & 0xffff0000u) * n0.y + __uint_as_float(qv.y << 16) * n0.z + __uint_as_float(qv.y & 0xffff0000u) * n0.w
                        + __uint_as_float(qv.z << 16) * n1.x + __uint_as_float(qv.z & 0xffff0000u) * n1.y + __uint_as_float(qv.w << 16) * n1.z + __uint_as_float(qv.w & 0xffff0000u) * n1.w; }
              accq += __shfl_xor(accq, 1); accq += __shfl_xor(accq, 2); accq += __shfl_xor(accq, 4);
              if (part == 0) qnL[t] = accq; }
            { int tz_ = tid; asm volatile("" : "+v"(tz_)); const int dp = tz_ & 63, lq = tz_ >> 6; float s0 = 0.f, s1 = 0.f;
#pragma unroll
              for (int i = 0; i < 8; ++i) { const int l = 8 * lq + i; const unsigned xv = *(const LAS unsigned*)(lds + ML_XC + swz256(l, dp >> 2) + 4 * (dp & 3)); const float w = wL[l];
                  s0 += w * __uint_as_float(xv << 16); s1 += w * __uint_as_float(xv & 0xffff0000u); }
              nred[lq * 128 + 2 * dp] = s0; nred[lq * 128 + 2 * dp + 1] = s1; }
            __syncthreads();
            const float decay = misc[1];
            ML_LANES();
            f32x4 hacc[4];
            { bf16x8 Cb[4];
#pragma unroll
              for (int s4 = 0; s4 < 4; ++s4) { u32x4 w; w.x = pg::cvt_pk_bf16(Cacc[2 * s4][0], Cacc[2 * s4][1]); w.y = pg::cvt_pk_bf16(Cacc[2 * s4][2], Cacc[2 * s4][3]); w.z = pg::cvt_pk_bf16(Cacc[2 * s4 + 1][0], Cacc[2 * s4 + 1][1]); w.w = pg::cvt_pk_bf16(Cacc[2 * s4 + 1][2], Cacc[2 * s4 + 1][3]); Cb[s4] = __builtin_bit_cast(bf16x8, w); }
              const int xfi = ((fr & 3) << 2) | ((fr >> 2) & 3), ib_ = 256 * fr + 16 * ((g >> 1) ^ (xfi & 3)) + 8 * (g & 1);
#pragma unroll
              for (int tt = 0; tt < 4; ++tt) { f32x4 z = (f32x4){0.f, 0.f, 0.f, 0.f};
                  if (tt == 2) asm volatile("" ::: "memory");
#pragma unroll
                  for (int s4 = 0; s4 < 4; ++s4) { const int io = ib_ + ((s4 ^ (xfi >> 2)) << 6);
                      const u32x2 lo = *(const LAS u32x2*)(lds + ML_QP + 4096 * tt + io), hi = *(const LAS u32x2*)(lds + ML_QP + 4096 * tt + (io ^ 32));
                      const u32x4 w = (u32x4){lo.x, lo.y, hi.x, hi.y};
                      z = __builtin_amdgcn_mfma_f32_16x16x32_bf16(__builtin_bit_cast(bf16x8, w), Cb[s4], z, 0, 0, 0); }
                  const f32x4 wi = *(const LAS f32x4*)(wiL + 16 * tt + 4 * g);
                  hacc[tt] = z * wi; } }
            bf16x8 Vb[2];
            const int rl0 = (8 * g + q_) & 15, rl1 = (8 * g + q_ + 4) & 15;
            const int xt0 = ((rl0 & 3) << 2) | ((rl0 >> 2) & 3), xt1 = ((rl1 & 3) << 2) | ((rl1 >> 2) & 3);
            const int tr0 = 256 * (8 * g + q_) + 8 * (pp & 1), tr1 = tr0 + 1024;
#pragma unroll
            for (int s2 = 0; s2 < 2; ++s2) {
                const s16x4 v0 = __builtin_amdgcn_ds_read_tr16_b64_v4i16((LAS s16x4*)(lds + ML_VV + 8192 * s2 + tr0 + 16 * ((2 * wave + (pp >> 1)) ^ xt0)));
                const s16x4 v1 = __builtin_amdgcn_ds_read_tr16_b64_v4i16((LAS s16x4*)(lds + ML_VV + 8192 * s2 + tr1 + 16 * ((2 * wave + (pp >> 1)) ^ xt1)));
                Vb[s2] = (bf16x8){v0[0], v0[1], v0[2], v0[3], v1[0], v1[1], v1[2], v1[3]}; }
#pragma unroll
            for (int tt = 0; tt < 4; ++tt) { const int rt = 16 * tt + fr;
#pragma unroll
                for (int s2 = 0; s2 < 2; ++s2) { const bf16x8 pa = *(const LAS bf16x8*)(lds + ML_PM + rt * 128 + (((4 * s2 + g) ^ (rt & 7)) << 4));
                    hacc[tt] = __builtin_amdgcn_mfma_f32_16x16x32_bf16(pa, Vb[s2], hacc[tt], 0, 0, 0); } }
            { const int taum = 16 * (fr >> 2) + 4 * g + (fr & 3);
              const float den = wiL[taum] * qnL[taum] + ((rs[taum] + rs[64 + taum]) + (rs[128 + taum] + rs[192 + taum]));
              const float rdm = frcp(fmaxf(fabsf(den), emtL[taum]));
#pragma unroll
              for (int tt = 0; tt < 4; ++tt)
#pragma unroll
                  for (int r = 0; r < 4; ++r) hacc[tt][r] *= __shfl(rdm, (lane & 48) + 4 * tt + r); }
            if (ci < 16) {
#pragma unroll
                for (int tt = 0; tt < 4; ++tt) { const unsigned off = (unsigned)((((ci * 8 + wave) * 4 + tt) * 64 + lane) * 16);
                    __builtin_amdgcn_raw_buffer_store_b128((u32x4){__float_as_uint(hacc[tt][0]), __float_as_uint(hacc[tt][1]), __float_as_uint(hacc[tt][2]), __float_as_uint(hacc[tt][3])}, rs_mine, off, 0, 16); }
            } else {
                float v16[16];
#pragma unroll
                for (int tt = 0; tt < 4; ++tt)
#pragma unroll
                    for (int r = 0; r < 4; ++r) { hacc[tt][r] += hfr[tt * 4 + r]; v16[tt * 4 + r] = hacc[tt][r] * hacc[tt][r]; }
                float a8[8], a4[4], a2[2];
                const bool h3 = lane & 8, h2 = lane & 4, h1 = lane & 2, h0 = lane & 1;
#pragma unroll
                for (int i = 0; i < 8; ++i) { const float send = h3 ? v16[i] : v16[i + 8], keep = h3 ? v16[i + 8] : v16[i]; a8[i] = keep + __shfl_xor(send, 8); }
#pragma unroll
                for (int i = 0; i < 4; ++i) { const float send = h2 ? a8[i] : a8[i + 4], keep = h2 ? a8[i + 4] : a8[i]; a4[i] = keep + __shfl_xor(send, 4); }
#pragma unroll
                for (int i = 0; i < 2; ++i) { const float send = h1 ? a4[i] : a4[i + 2], keep = h1 ? a4[i + 2] : a4[i]; a2[i] = keep + __shfl_xor(send, 2); }
                float tot; { const float send = h0 ? a2[0] : a2[1], keep = h0 ? a2[1] : a2[0]; tot = keep + __shfl_xor(send, 1); }
                ssq[wave * 64 + 16 * (fr >> 2) + 4 * g + (fr & 3)] = tot;
            }
            { bf16x8 Wb[2];
#pragma unroll
              for (int s2 = 0; s2 < 2; ++s2) { const f32x4 w0 = *(const LAS f32x4*)(wL + 32 * s2 + 8 * g), w1 = *(const LAS f32x4*)(wL + 32 * s2 + 8 * g + 4); u32x4 o;
                  const u32x4 vb = __builtin_bit_cast(u32x4, Vb[s2]);
                  o.x = pk2(__uint_as_float(vb.x << 16) * w0.x, __uint_as_float(vb.x & 0xffff0000u) * w0.y); o.y = pk2(__uint_as_float(vb.y << 16) * w0.z, __uint_as_float(vb.y & 0xffff0000u) * w0.w);
                  o.z = pk2(__uint_as_float(vb.z << 16) * w1.x, __uint_as_float(vb.z & 0xffff0000u) * w1.y); o.w = pk2(__uint_as_float(vb.w << 16) * w1.z, __uint_as_float(vb.w & 0xffff0000u) * w1.w);
                  Wb[s2] = __builtin_bit_cast(bf16x8, o); }
#pragma unroll
              for (int dt = 0; dt < 8; ++dt) { Cacc[dt] = Cacc[dt] * decay;
                  const int xo0 = tr0 + 16 * ((2 * dt + (pp >> 1)) ^ xt0), xo1 = tr1 + 16 * ((2 * dt + (pp >> 1)) ^ xt1);
#pragma unroll
                  for (int s2 = 0; s2 < 2; ++s2) {
                      const s16x4 x0 = __builtin_amdgcn_ds_read_tr16_b64_v4i16((LAS s16x4*)(lds + ML_XC + 8192 * s2 + xo0));
                      const s16x4 x1 = __builtin_amdgcn_ds_read_tr16_b64_v4i16((LAS s16x4*)(lds + ML_XC + 8192 * s2 + xo1));
                      const bf16x8 xa = (bf16x8){x0[0], x0[1], x0[2], x0[3], x1[0], x1[1], x1[2], x1[3]};
                      Cacc[dt] = __builtin_amdgcn_mfma_f32_16x16x32_bf16(xa, Wb[s2], Cacc[dt], 0, 0, 0); } } }
            if (cdo) titem_store(ct, creg, lds + 106752 + wave * 6144, lane);
            if (tid < 128) { float sN = 0.f;
#pragma unroll
                for (int qq = 0; qq < 8; ++qq) sN += nred[qq * 128 + tid];
                nL[tid] = decay * nL[tid] + sN; }
            if (tid == 0) misc[0] = misc[2];
            if (ci >= 16) {
                __syncthreads();
                float rimine; { const int taum = 16 * (fr >> 2) + 4 * g + (fr & 3); float s2 = 0.f;
#pragma unroll
                    for (int w8 = 0; w8 < 8; ++w8) s2 += ssq[w8 * 64 + taum];
                    rimine = rsqrtf(s2 * (1.0f / 128) + EPS); }
#pragma unroll
                for (int tt = 0; tt < 4; ++tt)
#pragma unroll
                    for (int r = 0; r < 4; ++r) { const int tau = 16 * tt + 4 * g + r, tok = tb + (dir ? 63 - tau : tau);
                        const float ri = __shfl(rimine, (lane & 48) + 4 * tt + r); const int e = 16 * wave + fr;
                        const float xcv = bf2f(*(const LAS bf16_t*)(lds + ML_XC + swz256(tau, e >> 3) + 2 * (e & 7)));
                        const float op = opr[tt * 4 + r];
                        YM[(size_t)tok * KP + e] = f2bf((hacc[tt][r] * ri * ng + sk * xcv) * frcp(1.0f + fexp(-op))); }
            }
            __syncthreads();
        }
    }
}

#undef ML_LANES
#undef ML_PREFETCH
__global__ void __launch_bounds__(NWAVES * 64, 2) mk_fwd(MkArgs args) {
    extern __shared__ __attribute__((aligned(16))) unsigned char lds_raw[];
    LAS unsigned char* lds = (LAS unsigned char*)lds_raw;
    const int tid = threadIdx.x, lane = tid & 63, wave = __builtin_amdgcn_readfirstlane(tid >> 6);
    const int G = gridDim.x, bx = blockIdx.x;
    unsigned char* ws = args.ws;
    volatile LAS unsigned* MISC = (volatile LAS unsigned*)(lds + MISC_OFF);
    if (tid < 64) MISC[tid] = 0u;
    __syncthreads();
    XcdBarrier bar = xcd_barrier_post((unsigned*)(ws + WS_CTL) + 4096 + args.li * 4096, MISC + 8);
    const int lo = args.ph_lo, hi = args.ph_hi;
#define IN(k) (lo <= (k) && (k) < hi)
#define SEAM(k) do { if (IN(k) && IN((k) + 1)) xcd_barrier(bar); } while (0)

    if (IN(0)) p0_phase(args, lds, G, bx, tid, lane, wave);
    SEAM(0);
    if (IN(1)) norm_phase<0>(args, lds, G, bx, tid, lane, wave);
    SEAM(1);
    if (IN(2)) {
        unsigned voffA[2][2], voffB[2]; pg::plain_voff(voffA[0], KP, false); voffA[1][0] = voffA[0][0]; voffA[1][1] = voffA[0][1]; pg::head_voff(voffB, KP);
        P2Tiles TS{(const char*)(ws + WS_HB), (const char*)(ws + WS_WIN), G, bx}; P2Epi E{(bf16_t*)(ws + WS_XM), args.in[15], args.in[16], G, bx};
        pg::gemm_stream<true>(lds, D, TS, E, voffA, voffB);
    }
    SEAM(2);
    if (IN(3)) {
        if (bx < 128) { if (args.pad != 2) mlstm_unit(args, lds, bx, tid, lane, wave); }
        else if (args.pad != 1) { attn_unit(args, lds, bx - 128, (bx - 128) * 8 + wave, tid, lane, wave); }
    }
    SEAM(3);
    if (IN(4)) {
        unsigned voffA[2][2], voffB[2]; pg::plain_voff(voffA[0], KP, false); voffA[1][0] = voffA[0][0]; voffA[1][1] = voffA[0][1]; pg::plain_voff(voffB, KP, true);
        P4Tiles TS{(const char*)(ws + WS_YCAT), (const char*)(ws + WS_WOUT), G, bx}; P4Epi E{(const float*)(ws + WS_MOD), (bf16_t*)(ws + WS_MIX), G, bx};
        pg::gemm_stream<true>(lds, D, TS, E, voffA, voffB);
    }
    SEAM(4);
    if (IN(5)) norm_phase<1>(args, lds, G, bx, tid, lane, wave);
    SEAM(5);
    LAS int* idxs = (LAS int*)(lds + TAB_OFF); LAS float* gsl = (LAS float*)(lds + TAB_OFF + 1024);
    if (IN(6)) {
        const int be = bx, b = (be >> 4) & 15, e = be & 15;
        topk_sort((const float*)(ws + WS_AFF) + (size_t)be * S, (LAS unsigned long long*)lds, idxs, gsl, (float*)(ws + WS_GSEL) + (size_t)be * CAP, (unsigned short*)(ws + WS_INV) + (size_t)be * S, tid);
        bf16_t* hid = (bf16_t*)(ws + WS_HID) + (size_t)be * CAP * HIDP;
        unsigned voffA[2][2], voffB[2];
#pragma unroll
        for (int i = 0; i < 2; ++i) { int R, C; int tz = threadIdx.x; asm volatile("" : "+v"(tz)); pg::stage_rc(tz * 16 + i * 8192, R, C); voffA[0][i] = (unsigned)(idxs[R] * KP + C) * 2u; voffA[1][i] = (unsigned)(idxs[128 + R] * KP + C) * 2u; }
        pg::plain_voff(voffB, KP, true);
        F1Tiles TS{(const char*)(ws + WS_HB) + (size_t)b * S * KP * 2, (const char*)(ws + WS_WG) + (size_t)e * DFF * KP * 2, (const char*)(ws + WS_WU) + (size_t)e * DFF * KP * 2}; F1Epi E{hid};
        pg::gemm_stream<true>(lds, D, TS, E, voffA, voffB);
    }
    SEAM(6);
    if (IN(7)) {
        unsigned voffA[2][2], voffB[2]; pg::plain_voff(voffA[0], HIDP, false); voffA[1][0] = voffA[0][0]; voffA[1][1] = voffA[0][1]; pg::plain_voff(voffB, HIDP, true);
        F2Tiles TS{(const char*)(ws + WS_HID), (const char*)(ws + WS_WD), bx & 7, (bx >> 3) & 31}; F2Epi E{(bf16_t*)(ws + WS_Y), (const float*)(ws + WS_GSEL), bx & 7, (bx >> 3) & 31};
        pg::gemm_stream<true>(lds, DFF, TS, E, voffA, voffB);
    }
    SEAM(7);
    if (IN(8)) {
        const unsigned short* inv = (const unsigned short*)(ws + WS_INV); const bf16_t* Y = (const bf16_t*)(ws + WS_Y);
        const int gw = bx * 8 + wave, m0 = gw * 16, b = m0 >> 11, s0 = m0 & 2047;
        const float* g2 = (const float*)(ws + WS_MOD) + (size_t)b * 6144 + 5120 + 16 * lane;
        f32x4 gv[4];
#pragma unroll
        for (int j = 0; j < 4; ++j) gv[j] = *(const f32x4*)(g2 + 4 * j);
        unsigned ivr[4];
#pragma unroll
        for (int j = 0; j < 4; ++j) ivr[j] = inv[(size_t)(b * 16 + (lane & 15)) * S + s0 + 4 * (lane >> 4) + j];
#pragma unroll 2
        for (int i = 0; i < 16; ++i) { const int m = m0 + i;
            float* orow = args.out + (size_t)m * D + 16 * lane;
            f32x4 xv[4];
#pragma unroll
            for (int j = 0; j < 4; ++j) xv[j] = *(const f32x4*)(orow + 4 * j);
            const unsigned ivsel = (i & 3) == 0 ? ivr[0] : ((i & 3) == 1 ? ivr[1] : ((i & 3) == 2 ? ivr[2] : ivr[3]));
            float accv[16];
#pragma unroll
            for (int j = 0; j < 16; ++j) accv[j] = 0.f;
            unsigned msk = (unsigned)((__ballot(ivsel != 0xFFFFu) >> (16 * (i >> 2))) & 0xFFFFull);
            while (msk) {
                int ee[4]; bool hv[4];
#pragma unroll
                for (int q = 0; q < 4; ++q) { hv[q] = msk != 0u; ee[q] = hv[q] ? (int)__builtin_ctz(msk) : 0; if (hv[q]) msk &= msk - 1u; }
                u32x4 y0[4], y1[4];
#pragma unroll
                for (int q = 0; q < 4; ++q) if (hv[q]) { const unsigned c = (unsigned)__shfl((int)ivsel, 16 * (i >> 2) + ee[q]); const bf16_t* yr = Y + ((size_t)(b * 16 + ee[q]) * CAP + c) * D + 16 * lane; y0[q] = *(const u32x4*)yr; y1[q] = *(const u32x4*)(yr + 8); }
#pragma unroll
                for (int q = 0; q < 4; ++q) if (hv[q]) {
#pragma unroll
                    for (int j = 0; j < 4; ++j) { accv[2 * j] += __uint_as_float(y0[q][j] << 16); accv[2 * j + 1] += __uint_as_float(y0[q][j] & 0xffff0000u); accv[8 + 2 * j] += __uint_as_float(y1[q][j] << 16); accv[8 + 2 * j + 1] += __uint_as_float(y1[q][j] & 0xffff0000u); } }
            }
#pragma unroll
            for (int j = 0; j < 4; ++j) *(f32x4*)(orow + 4 * j) = xv[j] + gv[j] * (f32x4){accv[4 * j], accv[4 * j + 1], accv[4 * j + 2], accv[4 * j + 3]}; }
    }
#undef IN
#undef SEAM
}

extern "C" void kernel_launch(void* const* d_in, const int* in_sizes, int n_in, void* d_out, int out_size, void* d_ws, size_t ws_size, hipStream_t stream) {
    static int ok = 0;
    if (!ok) {
        if (n_in != 25 || in_sizes[0] != T * D || out_size != T * D || ws_size < WS_END) { fprintf(stderr, "kernel_launch: unexpected shapes (n_in %d, in0 %d, out %d, ws %zu)\n", n_in, n_in > 0 ? in_sizes[0] : -1, out_size, ws_size); ok = -1; return; }
        if (hipFuncSetAttribute((const void*)mk_fwd, hipFuncAttributeMaxDynamicSharedMemorySize, LDS_BYTES) != hipSuccess) { fprintf(stderr, "hipFuncSetAttribute(mk_fwd) failed\n"); ok = -1; return; }
        { int dev = 0, cus = 0, per_cu = 0; hipGetDevice(&dev); hipDeviceGetAttribute(&cus, hipDeviceAttributeMultiprocessorCount, dev);
          hipOccupancyMaxActiveBlocksPerMultiprocessor(&per_cu, (const void*)mk_fwd, NWAVES * 64, LDS_BYTES); (void)hipGetLastError();
          if (cus < 256 || per_cu < 1) { fprintf(stderr, "kernel_launch: needs 256 CUs with one resident 512-thread workgroup each (cus %d, per_cu %d)\n", cus, per_cu); ok = -1; return; } }
        ok = 1;
    }
    if (ok < 0) return;
    unsigned char* ws = (unsigned char*)d_ws; float* out = (float*)d_out;
    hipMemsetAsync(ws + WS_CTL, 0, 1 * MiB, stream);
    int nl = 0; MkArgs ma{}; for (int i = 0; i < 25; ++i) ma.in[i] = (const float*)d_in[i]; ma.out = out; ma.ws = ws;
#define MKM(lo_, hi_, md_) do { ma.pad = (md_); MK(lo_, hi_); ma.pad = 0; } while (0)
#define MK(lo_, hi_) do { ma.ph_lo = (lo_); ma.ph_hi = (hi_); ma.li = nl++; hipLaunchKernelGGL(mk_fwd, dim3(256), dim3(NWAVES * 64), LDS_BYTES, stream, ma); } while (0)
    MK(0, 9);
}
```

```cpp
#include <hip/hip_runtime.h>
#include <cstdio>
#include <cstdint>

constexpr int NB = 16, S = 2048, D = 1024, T = NB * S;
constexpr int NPROJ = 2560, PROJ_TOTAL = 2576;
constexpr int NEXP = 16, CAP = 256, DFF = 2048;
constexpr float EPS = 1e-6f;

typedef unsigned short bf16_t;
typedef float f32x4 __attribute__((ext_vector_type(4)));
typedef float f32x2 __attribute__((ext_vector_type(2)));
typedef unsigned u32x4 __attribute__((ext_vector_type(4)));
typedef unsigned u32x2 __attribute__((ext_vector_type(2)));

constexpr int KP = D + 64;
constexpr int KPB = D + 128;
constexpr int HIDPB = DFF + 128;
constexpr float Y_SCALE = 64.0f;
constexpr float HID_SCALE = 8.0f;
constexpr int HIDP = DFF + 64;
constexpr int PP = 512 + 64;
constexpr size_t MiB = 1u << 20;
constexpr size_t WS_CTL = 0;
constexpr size_t WS_MOD = 1 * MiB;
constexpr size_t WS_BIAS = 1 * MiB + 512 * 1024;
constexpr size_t WS_FSC = 1 * MiB + 768 * 1024;
constexpr size_t WS_WIN = 2 * MiB;
constexpr size_t WS_WOUT = 8 * MiB;
constexpr size_t WS_AFF = 2 * MiB;
constexpr size_t WS_INV = 4 * MiB;
constexpr size_t WS_GSEL = 5 * MiB;
constexpr size_t WS_WG = 12 * MiB, WS_WU = 80 * MiB, WS_WD = 148 * MiB;
constexpr size_t WS_YA = 250 * MiB, WS_YB = 418 * MiB;
__device__ __forceinline__ unsigned char* y_unit(unsigned char* ws, int be) { return be < 128 ? ws + WS_YA + (size_t)be * (256 * 1024) : ws + WS_YB + (size_t)(be - 128) * (256 * 1024); }
constexpr size_t WS_HB = 214 * MiB;
constexpr size_t WS_GATES = 282 * MiB;
constexpr size_t WS_PROJ = 284 * MiB, PROJ_STRIDE = 36 * MiB;
constexpr size_t WS_XM = WS_PROJ, WS_OPRE = WS_PROJ + PROJ_STRIDE, WS_AQ = WS_PROJ + 2 * PROJ_STRIDE, WS_AK = WS_PROJ + 3 * PROJ_STRIDE, WS_AV = WS_PROJ + 4 * PROJ_STRIDE;
constexpr size_t WS_MIX = 284 * MiB;
constexpr size_t WS_X1B = 464 * MiB;
constexpr size_t WS_YCAT = 464 * MiB;
constexpr size_t WS_LSE = 532 * MiB;
constexpr size_t WS_HID = 282 * MiB;
constexpr size_t WS_END = 546 * MiB;
static_assert((size_t)2560 * KP * 2 <= 6 * MiB && (size_t)1024 * KP * 2 <= 4 * MiB && (size_t)16 * 2048 * KP * 2 <= 68 * MiB && (size_t)16 * 1024 * HIDP * 2 <= 66 * MiB, "weight copies");
static_assert((size_t)T * KP * 2 <= 68 * MiB && (size_t)T * PP * 2 <= 36 * MiB && WS_HID + (size_t)256 * 256 * HIDP * 2 <= WS_END && (size_t)256 * 256 * 1024 * 2 <= 136 * MiB && WS_LSE + (size_t)T * 8 * 4 <= WS_END, "activation buffers");

__device__ __forceinline__ float bf2f(bf16_t v) { return __uint_as_float(((unsigned)v) << 16); }
__device__ __forceinline__ bf16_t f2bf(float f) { unsigned u = __float_as_uint(f); return (bf16_t)((u + 0x7fffu + ((u >> 16) & 1u)) >> 16); }
__device__ __forceinline__ unsigned pk2(float lo, float hi) { unsigned r; asm("v_cvt_pk_bf16_f32 %0, %1, %2" : "=v"(r) : "v"(lo), "v"(hi)); return r; }
__device__ __forceinline__ float frcp(float x) { return __builtin_amdgcn_rcpf(x); }
__device__ __forceinline__ float fexp(float x) { return __builtin_amdgcn_exp2f(x * 1.4426950408889634f); }
__device__ __forceinline__ float fexp2(float x) { return __builtin_amdgcn_exp2f(x); }
__device__ __forceinline__ float wave_sum(float v) {
#pragma unroll
    for (int o = 1; o < 64; o <<= 1) v += __shfl_xor(v, o);
    return v;
}
__device__ __forceinline__ float silu_f(float x) { return x * __builtin_amdgcn_rcpf(1.0f + __expf(-x)); }
__device__ __forceinline__ float sigmoid_f(float x) { return __builtin_amdgcn_rcpf(1.0f + __expf(-x)); }
__device__ __forceinline__ float log_sigmoid_f(float z) { return fminf(z, 0.0f) - log1pf(__expf(-fabsf(z))); }

__device__ int t5_bucket(int rel) {
    const int n = rel < 0 ? -rel : rel;
    const float lr = logf((float)(n > 1 ? n : 1) / 8.0f) / 4.852030263919617f;
    int large = 8 + (int)(lr * 8.0f); if (large > 15) large = 15;
    return (rel > 0 ? 16 : 0) + (n < 8 ? n : large);
}

#define LAS __attribute__((address_space(3)))
typedef short bf16x8 __attribute__((ext_vector_type(8)));
constexpr int NWAVES = 8;
constexpr int RING_BYTES = 131072;
constexpr int LDS_BYTES = 163840;
constexpr int MISC_OFF = LDS_BYTES - 4096;
constexpr int TAB_OFF = MISC_OFF + 1024;

#define XB_TMO      128
#define XB_XCNT(j)  (256  + 64 * (j))
#define XB_XSUB(j)  (1280 + 64 * (j))
#define XB_XGEN(j)  (2304 + 64 * (j))
#define XB_TOP      3328
#define XB_TOPGEN   3392
#define XCD_BAR_WORDS 3456
#define XB_SPIN_CAP (1u << 18)
__device__ __forceinline__ unsigned xb_ld(unsigned* p)              { return __hip_atomic_load(p, __ATOMIC_RELAXED, __HIP_MEMORY_SCOPE_AGENT); }
__device__ __forceinline__ unsigned xb_add(unsigned* p, unsigned v) { return __hip_atomic_fetch_add(p, v, __ATOMIC_RELAXED, __HIP_MEMORY_SCOPE_AGENT); }
__device__ __forceinline__ unsigned xb_xcc_id() { return (unsigned)__builtin_amdgcn_s_getreg((3 << 11) | 20) & 0xFu; }
#define XB_SPIN(cond, bar) do { unsigned _sp = 0; while (cond) { __builtin_amdgcn_s_sleep(1); \
    if ((++_sp & 255u) == 0u) { if (xb_ld(&(bar)[XB_TMO])) break; if (_sp > XB_SPIN_CAP) { atomicAdd(&(bar)[XB_TMO], 1u); break; } } } } while (0)
struct XcdBarrier { unsigned* bar; unsigned x; volatile LAS unsigned* st; };
__device__ __forceinline__ XcdBarrier xcd_barrier_post(unsigned* bar, volatile LAS unsigned* st) {
    XcdBarrier b; b.bar = bar; b.x = xb_xcc_id(); b.st = st;
    if (threadIdx.x == 0) (void)xb_add(&bar[XB_XCNT(b.x)], 1u);
    return b;
}
__device__ __forceinline__ void xcd_barrier_complete(unsigned* bar, unsigned x, unsigned& nloc, unsigned& nx) {
    const unsigned G = gridDim.x * gridDim.y * gridDim.z;
    unsigned sum, cnt, mine, sp = 0u;
    for (;;) {
        sum = 0u; cnt = 0u; mine = 0u;
#pragma unroll
        for (unsigned j = 0; j < 16; ++j) { const unsigned c = xb_ld(&bar[XB_XCNT(j)]); sum += c; cnt += (c > 0u) ? 1u : 0u; mine = (j == x) ? c : mine; }
        if (sum == G) break;
        __builtin_amdgcn_s_sleep(1);
        if ((++sp & 255u) == 0u) { if (xb_ld(&bar[XB_TMO])) break; if (sp > XB_SPIN_CAP) { atomicAdd(&bar[XB_TMO], 1u); break; } }
    }
    nloc = mine > 0u ? mine : 1u; nx = cnt > 0u ? cnt : 1u;
}
__device__ __forceinline__ void xcd_barrier(const XcdBarrier& b) {
    asm volatile("s_waitcnt vmcnt(0)" ::: "memory");
    __syncthreads();
    if (threadIdx.x == 0) {
        unsigned* bar = b.bar;
        __builtin_amdgcn_s_waitcnt(0);
        unsigned nloc = b.st[0], nx = b.st[1];
        if (nloc == 0u) { xcd_barrier_complete(bar, b.x, nloc, nx); b.st[0] = nloc; b.st[1] = nx; }
        const unsigned old = xb_add(&bar[XB_XSUB(b.x)], 1u);
        const unsigned gen = old / nloc;
        if (old + 1u == (gen + 1u) * nloc) {
            __builtin_amdgcn_fence(__ATOMIC_RELEASE, "agent");
            asm volatile("s_waitcnt vmcnt(0)" ::: "memory");
            const unsigned og = xb_add(&bar[XB_TOP], 1u);
            const unsigned tg = og / nx;
            if (og + 1u == (tg + 1u) * nx) xb_add(&bar[XB_TOPGEN], 1u);
            else XB_SPIN(xb_ld(&bar[XB_TOPGEN]) == tg, bar);
            __builtin_amdgcn_fence(__ATOMIC_ACQUIRE, "agent");
            xb_add(&bar[XB_XGEN(b.x)], 1u);
            asm volatile("s_waitcnt vmcnt(0)" ::: "memory");
        } else {
            XB_SPIN(xb_ld(&bar[XB_XGEN(b.x)]) == gen, bar);
            __builtin_amdgcn_fence(__ATOMIC_ACQUIRE, "agent");
            asm volatile("s_waitcnt vmcnt(0)" ::: "memory");
        }
    }
    __syncthreads();
}

namespace pg {
constexpr int BM = 256, BK = 64, HALF = 128, HTB = HALF * BK * 2, STAGE_BYTES = 8 * HTB, NXCD = 8, WGM = 8;
__host__ __device__ __forceinline__ int lds_byte(int r, int c) { const int st = (r >> 4) * 2 + (c >> 5), rr = r & 15, cc = c & 31, ob = rr * 64 + cc * 2; return st * 1024 + (ob ^ (((ob >> 9) & 1) << 5)); }
__host__ __device__ __forceinline__ void stage_rc(int b, int& R, int& C) { const int st = b / 1024, sb = b % 1024, swz = sb ^ (((sb >> 9) & 1) << 5); R = (st >> 1) * 16 + swz / 64; C = (st & 1) * 32 + (swz % 64) / 2; }
__host__ __device__ __forceinline__ int perm32(int rho) { const int n = rho >> 4, i = rho & 15; return 8 * (i >> 2) + 4 * n + (i & 3); }
__device__ __forceinline__ unsigned cvt_pk_bf16(float lo, float hi) { unsigned r; asm volatile("v_cvt_pk_bf16_f32 %0, %1, %2" : "=v"(r) : "v"(lo), "v"(hi)); return r; }

struct Tile { const char* a0; const char* a1; const char* b0; const char* b1; };
__device__ __forceinline__ bool static_unit(int i, int G, int c, int nM, int nN, int& pm, int& pn) {
    const int nwg = nM * nN; const long L = (long)i * G + c; if (L >= nwg) return false;
    int wgid = (int)L; { const int q = nwg / NXCD, r = nwg % NXCD, xcd = wgid % NXCD, off = wgid / NXCD; wgid = (xcd < r ? xcd * (q + 1) : r * (q + 1) + (xcd - r) * q) + off; }
    const int nig = WGM * nN, gid = wgid / nig, fm = gid * WGM, gsz = (nM - fm) < WGM ? (nM - fm) : WGM;
    pm = fm + ((wgid % nig) % gsz); pn = (wgid % nig) / gsz; return true;
}
template <bool TR, class Tiles, class Epi>
__device__ __forceinline__ void gemm_stream(LAS unsigned char* lds, const int K, const Tiles& TS, const Epi& E, const unsigned (&voffA)[2][2], const unsigned (&voffB)[2]) {
    int tid = threadIdx.x; asm volatile("" : "+v"(tid));
    const int wid = __builtin_amdgcn_readfirstlane(tid >> 6), lane = tid & 63, wr = wid >> 2, wc = wid & 3, fr = lane & 15, fq = lane >> 4;
    const int nt = K / BK;
    const size_t kstep = (size_t)(BK * 2);
    const unsigned ldsw = (unsigned)wid * 1024u, ldsb = (unsigned)(unsigned long long)lds;
    const int aoff = lds_byte(wr * 64 + fr, fq * 8), boff = lds_byte(wc * 32 + fr, fq * 8);
#define PG_SA(b, h) (((b) * 2 + (h)) * HTB)
#define PG_SB(b, h) ((4 + (b) * 2 + (h)) * HTB)
#define PG_STAGE(bufoff, gbase, voff) do { const unsigned long long ga_ = (unsigned long long)(const char*)(gbase); \
        const unsigned long long gs_ = ((unsigned long long)(unsigned)__builtin_amdgcn_readfirstlane((unsigned)(ga_ >> 32)) << 32) | (unsigned long long)(unsigned)__builtin_amdgcn_readfirstlane((unsigned)ga_); \
        _Pragma("unroll") for (int _i = 0; _i < 2; ++_i) { unsigned keep_; const unsigned ld_ = (unsigned)__builtin_amdgcn_readfirstlane((int)(ldsb + (unsigned)(bufoff) + ldsw + _i * 8192)); \
            asm volatile("s_mov_b32 %0, m0\n\ts_mov_b32 m0, %3\n\ts_nop 0\n\tglobal_load_lds_dwordx4 %1, %2\n\ts_mov_b32 m0, %0" : "=&s"(keep_) : "v"((voff)[_i]), "s"(gs_), "s"(ld_) : "memory"); } } while (0)
#define PG_LDA(dst, b, h) do { _Pragma("unroll") for (int m = 0; m < 4; ++m) _Pragma("unroll") for (int k = 0; k < 2; ++k) dst[m][k] = *(const LAS bf16x8*)(lds + PG_SA(b, h) + aoff + m * 2048 + k * 1024); } while (0)
#define PG_LDB(dst, b, h) do { _Pragma("unroll") for (int n = 0; n < 2; ++n) _Pragma("unroll") for (int k = 0; k < 2; ++k) dst[n][k] = *(const LAS bf16x8*)(lds + PG_SB(b, h) + boff + n * 2048 + k * 1024); } while (0)
#define PG_MMA(ai, bj, At, Bt) do { __builtin_amdgcn_s_setprio(1); _Pragma("unroll") for (int m = 0; m < 4; ++m) _Pragma("unroll") for (int n = 0; n < 2; ++n) _Pragma("unroll") for (int k = 0; k < 2; ++k) \
        acc[ai][bj][m][n] = TR ? __builtin_amdgcn_mfma_f32_16x16x32_bf16(Bt[n][k], At[m][k], acc[ai][bj][m][n], 0, 0, 0) : __builtin_amdgcn_mfma_f32_16x16x32_bf16(At[m][k], Bt[n][k], acc[ai][bj][m][n], 0, 0, 0); __builtin_amdgcn_s_setprio(0); } while (0)
#define PG_WAIT_V(n) asm volatile("s_waitcnt vmcnt(" #n ")" ::: "memory")
#define PG_WAIT_L(n) asm volatile("s_waitcnt lgkmcnt(" #n ")" ::: "memory")
#define PG_BAR __builtin_amdgcn_s_barrier()
#define PG_SCHED __builtin_amdgcn_sched_barrier(0)
    Tile cur, nxt; int ui = 0;
    if (!TS.get(0, cur)) return;
    f32x4 acc[2][2][4][2];
#pragma unroll
    for (int a = 0; a < 2; ++a)
#pragma unroll
        for (int b = 0; b < 2; ++b)
#pragma unroll
            for (int m = 0; m < 4; ++m)
#pragma unroll
                for (int n = 0; n < 2; ++n) acc[a][b][m][n] = (f32x4){0.f, 0.f, 0.f, 0.f};
    bf16x8 At[4][2], B0[2][2], B1[2][2];
    PG_STAGE(PG_SB(0, 0), cur.b0, voffB); PG_STAGE(PG_SB(0, 1), cur.b1, voffB); PG_STAGE(PG_SA(0, 0), cur.a0, voffA[0]); PG_STAGE(PG_SA(0, 1), cur.a1, voffA[1]);
    if (wr == 1) PG_BAR;
    PG_WAIT_V(2); PG_BAR;
    PG_STAGE(PG_SB(1, 0), cur.b0 + kstep, voffB); PG_STAGE(PG_SA(1, 0), cur.a0 + kstep, voffA[0]); PG_STAGE(PG_SB(1, 1), cur.b1 + kstep, voffB);
    PG_WAIT_V(6); PG_BAR;
    for (;;) {
        const bool has_next = TS.get(ui + 1, nxt);
        if (!has_next) nxt = cur;
        for (int t = 0; t < nt; t += 2) {
            const bool last = (t == nt - 2);
            const char* a1h1 = cur.a1 + (size_t)(t + 1) * kstep;
            const char* a2h0 = last ? nxt.a0 : cur.a0 + (size_t)(t + 2) * kstep; const char* a2h1 = last ? nxt.a1 : cur.a1 + (size_t)(t + 2) * kstep;
            const char* b2h0 = last ? nxt.b0 : cur.b0 + (size_t)(t + 2) * kstep; const char* b2h1 = last ? nxt.b1 : cur.b1 + (size_t)(t + 2) * kstep;
            PG_LDB(B0, 0, 0); PG_LDB(B1, 0, 1); PG_SCHED; PG_LDA(At, 0, 0); PG_STAGE(PG_SA(1, 1), a1h1, voffA[1]);
            PG_WAIT_V(8); PG_WAIT_L(0); PG_BAR; PG_MMA(0, 0, At, B0); PG_MMA(0, 1, At, B1); PG_BAR; PG_SCHED;
            PG_LDA(At, 0, 1); PG_STAGE(PG_SB(0, 0), b2h0, voffB); PG_STAGE(PG_SB(0, 1), b2h1, voffB); PG_STAGE(PG_SA(0, 0), a2h0, voffA[0]);
            PG_WAIT_V(8); PG_WAIT_L(0); PG_BAR; PG_MMA(1, 0, At, B0); PG_MMA(1, 1, At, B1); PG_BAR; PG_SCHED;
            PG_LDB(B0, 1, 0); PG_LDB(B1, 1, 1); PG_SCHED; PG_LDA(At, 1, 0); PG_STAGE(PG_SA(0, 1), a2h1, voffA[1]);
            PG_WAIT_V(8); PG_WAIT_L(0); PG_BAR; PG_MMA(0, 0, At, B0); PG_MMA(0, 1, At, B1); PG_BAR; PG_SCHED;
            PG_LDA(At, 1, 1); PG_STAGE(PG_SB(1, 0), b2h0 + kstep, voffB); PG_STAGE(PG_SB(1, 1), b2h1 + kstep, voffB); PG_STAGE(PG_SA(1, 0), a2h0 + kstep, voffA[0]);
            PG_WAIT_V(8); PG_WAIT_L(0); PG_BAR; PG_MMA(1, 0, At, B0); PG_MMA(1, 1, At, B1); PG_BAR; PG_SCHED;
        }
        if (wr == 0) PG_BAR;
        E(acc, ui, wr, wc, fr, fq);
        if (!has_next) break;
#pragma unroll
        for (int a = 0; a < 2; ++a)
#pragma unroll
            for (int b = 0; b < 2; ++b)
#pragma unroll
                for (int m = 0; m < 4; ++m)
#pragma unroll
                    for (int n = 0; n < 2; ++n) acc[a][b][m][n] = (f32x4){0.f, 0.f, 0.f, 0.f};
        cur = nxt; ++ui;
        if (wr == 1) PG_BAR;
    }
    PG_WAIT_V(0);
    PG_BAR;
#undef PG_SA
#undef PG_SB
#undef PG_STAGE
#undef PG_LDA
#undef PG_LDB
#undef PG_MMA
#undef PG_WAIT_V
#undef PG_WAIT_L
#undef PG_BAR
#undef PG_SCHED
}
__device__ __forceinline__ void plain_voff(unsigned (&v)[2], int pitch, bool perm) {
    int tz = threadIdx.x; asm volatile("" : "+v"(tz));
#pragma unroll
    for (int i = 0; i < 2; ++i) { int R, C; stage_rc(tz * 16 + i * 8192, R, C); const int Rb = perm ? ((R & ~31) + perm32(R & 31)) : R; v[i] = (unsigned)(Rb * pitch + C) * 2u; }
}
__device__ __forceinline__ void head_voff(unsigned (&v)[2], int pitch) {
    int tz = threadIdx.x; asm volatile("" : "+v"(tz));
#pragma unroll
    for (int i = 0; i < 2; ++i) { int R, C; stage_rc(tz * 16 + i * 8192, R, C); const int Rb = 64 * ((R >> 5) & 3) + perm32(R & 31); v[i] = (unsigned)(Rb * pitch + C) * 2u; }
}
}

struct MkArgs { const float* in[25]; float* out; unsigned char* ws; int ph_lo, ph_hi, li, pad; };

struct P2Tiles { const char* A; const char* Bt; int G, c;
    __device__ __forceinline__ bool get(int i, pg::Tile& t) const { int pm, pn; if (!pg::static_unit(i, G, c, T / 256, NPROJ / 256, pm, pn)) return false;
        t.a0 = A + (size_t)pm * 256 * KP * 2; t.a1 = t.a0 + (size_t)128 * KP * 2; t.b0 = Bt + (size_t)pn * 256 * KP * 2; t.b1 = t.b0 + (size_t)32 * KP * 2; return true; } };
struct P2Epi { bf16_t* O; const float* gq; const float* gk; int G, c;
    __device__ __forceinline__ void operator()(const f32x4 (&acc)[2][2][4][2], int i, int wr, int wc, int fr, int fq) const {
        int pm, pn; pg::static_unit(i, G, c, T / 256, NPROJ / 256, pm, pn);
        const int colt = pn * 256, tsr = colt >> 9; bf16_t* base = O + (size_t)tsr * (PROJ_STRIDE / 2); const int col0 = (colt & 511) + wc * 64 + 8 * fq, row0 = pm * 256 + wr * 64 + fr;
        const bool nrm = (tsr == 2) || (tsr == 3);
        f32x4 gn[2][2];
        if (nrm) { const float* gp = (tsr == 2) ? gq : gk; const float sc = (tsr == 2) ? 0.125f * 1.4426950408889634f : 1.0f;
#pragma unroll
            for (int bj = 0; bj < 2; ++bj)
#pragma unroll
                for (int n = 0; n < 2; ++n) gn[bj][n] = *(const f32x4*)(gp + 32 * bj + 8 * fq + 4 * n) * sc; }
#pragma unroll
        for (int ai = 0; ai < 2; ++ai)
#pragma unroll
            for (int m = 0; m < 4; ++m) { bf16_t* rowp = base + (size_t)(row0 + ai * 128 + m * 16) * PP + col0;
                f32x4 v[2][2];
#pragma unroll
                for (int bj = 0; bj < 2; ++bj) { v[bj][0] = acc[ai][bj][m][0]; v[bj][1] = acc[ai][bj][m][1]; }
                if (nrm) { float ss = 0.f;
#pragma unroll
                    for (int bj = 0; bj < 2; ++bj)
#pragma unroll
                        for (int n = 0; n < 2; ++n) ss += v[bj][n].x * v[bj][n].x + v[bj][n].y * v[bj][n].y + v[bj][n].z * v[bj][n].z + v[bj][n].w * v[bj][n].w;
                    ss += __shfl_xor(ss, 16); ss += __shfl_xor(ss, 32);
                    const float ri = rsqrtf(ss * (1.0f / 64) + EPS);
#pragma unroll
                    for (int bj = 0; bj < 2; ++bj)
#pragma unroll
                        for (int n = 0; n < 2; ++n) v[bj][n] = v[bj][n] * ri * gn[bj][n]; }
#pragma unroll
                for (int bj = 0; bj < 2; ++bj) {
                    u32x4 w; w.x = pg::cvt_pk_bf16(v[bj][0][0], v[bj][0][1]); w.y = pg::cvt_pk_bf16(v[bj][0][2], v[bj][0][3]); w.z = pg::cvt_pk_bf16(v[bj][1][0], v[bj][1][1]); w.w = pg::cvt_pk_bf16(v[bj][1][2], v[bj][1][3]);
                    *(u32x4*)(rowp + bj * 32) = w; } }
    } };
struct P4Tiles { const char* A; const char* Bt; int G, c;
    __device__ __forceinline__ bool get(int i, pg::Tile& t) const { int pm, pn; if (!pg::static_unit(i, G, c, T / 256, D / 256, pm, pn)) return false;
        t.a0 = A + (size_t)pm * 256 * KP * 2; t.a1 = t.a0 + (size_t)128 * KP * 2; t.b0 = Bt + (size_t)pn * 256 * KP * 2; t.b1 = t.b0 + (size_t)128 * KP * 2; return true; } };
struct P4Epi { const float* mod; bf16_t* O; int G, c;
    __device__ __forceinline__ void operator()(const f32x4 (&acc)[2][2][4][2], int i, int wr, int wc, int fr, int fq) const {
        int pm, pn; pg::static_unit(i, G, c, T / 256, D / 256, pm, pn);
        const int row0 = pm * 256 + wr * 64 + fr, col0 = pn * 256 + wc * 32 + 8 * fq; const float* g1 = mod + (size_t)(pm >> 3) * 6144 + 2048;
        f32x4 gv[2][2];
#pragma unroll
        for (int bj = 0; bj < 2; ++bj)
#pragma unroll
            for (int n = 0; n < 2; ++n) gv[bj][n] = *(const f32x4*)(g1 + col0 + bj * 128 + n * 4);
#pragma unroll
        for (int ai = 0; ai < 2; ++ai)
#pragma unroll
            for (int m = 0; m < 4; ++m) { bf16_t* rowp = O + (size_t)(row0 + ai * 128 + m * 16) * D + col0;
#pragma unroll
                for (int bj = 0; bj < 2; ++bj) { const f32x4 v0 = acc[ai][bj][m][0] * gv[bj][0], v1 = acc[ai][bj][m][1] * gv[bj][1];
                    u32x4 w; w.x = pg::cvt_pk_bf16(v0[0], v0[1]); w.y = pg::cvt_pk_bf16(v0[2], v0[3]); w.z = pg::cvt_pk_bf16(v1[0], v1[1]); w.w = pg::cvt_pk_bf16(v1[2], v1[3]);
                    *(u32x4*)(rowp + bj * 128) = w; } }
    } };
struct F1Tiles { const char* A; const char* Wg; const char* Wu;
    __device__ __forceinline__ bool get(int i, pg::Tile& t) const { if (i >= 16) return false; t.a0 = A; t.a1 = A; t.b0 = Wg + (size_t)i * 128 * KP * 2; t.b1 = Wu + (size_t)i * 128 * KP * 2; return true; } };
struct F1Epi { bf16_t* hid;
    __device__ __forceinline__ void operator()(const f32x4 (&acc)[2][2][4][2], int i, int wr, int wc, int fr, int fq) const {
        const int row0 = wr * 64 + fr, col0 = i * 128 + wc * 32 + 8 * fq;
#pragma unroll
        for (int ai = 0; ai < 2; ++ai)
#pragma unroll
            for (int m = 0; m < 4; ++m) { float h[8];
#pragma unroll
                for (int n = 0; n < 2; ++n)
#pragma unroll
                    for (int j = 0; j < 4; ++j) { const float g = acc[ai][0][m][n][j], u = acc[ai][1][m][n][j]; h[n * 4 + j] = g * u * frcp(1.0f + fexp(-g)); }
                u32x4 w; w.x = pg::cvt_pk_bf16(h[0], h[1]); w.y = pg::cvt_pk_bf16(h[2], h[3]); w.z = pg::cvt_pk_bf16(h[4], h[5]); w.w = pg::cvt_pk_bf16(h[6], h[7]);
                *(u32x4*)(hid + (size_t)(row0 + ai * 128 + m * 16) * HIDP + col0) = w; }
    } };
struct F2Tiles { const char* hid; const char* Wd; int x, sl;
    __device__ __forceinline__ bool get(int i, pg::Tile& t) const { if (i >= 4) return false; const int e = 4 * i + (x >> 1), b = 8 * (x & 1) + (sl >> 2), pn = sl & 3, be = b * 16 + e;
        t.a0 = hid + (size_t)be * CAP * HIDP * 2; t.a1 = t.a0 + (size_t)128 * HIDP * 2; t.b0 = Wd + ((size_t)e * D + pn * 256) * HIDP * 2; t.b1 = t.b0 + (size_t)128 * HIDP * 2; return true; } };
struct F2Epi { bf16_t* Y; const float* gsel; int x, sl;
    __device__ __forceinline__ void operator()(const f32x4 (&acc)[2][2][4][2], int i, int wr, int wc, int fr, int fq) const {
        const int e = 4 * i + (x >> 1), b = 8 * (x & 1) + (sl >> 2), pn = sl & 3, be = b * 16 + e;
        const int row0 = wr * 64 + fr, col0 = pn * 256 + wc * 32 + 8 * fq;
        float gv[2][4];
#pragma unroll
        for (int ai = 0; ai < 2; ++ai)
#pragma unroll
            for (int m = 0; m < 4; ++m) gv[ai][m] = gsel[(size_t)be * CAP + row0 + ai * 128 + m * 16];
#pragma unroll
        for (int ai = 0; ai < 2; ++ai)
#pragma unroll
            for (int m = 0; m < 4; ++m) { const int r = row0 + ai * 128 + m * 16; bf16_t* rowp = Y + ((size_t)be * CAP + r) * D + col0;
#pragma unroll
                for (int bj = 0; bj < 2; ++bj) { const f32x4 v0 = acc[ai][bj][m][0] * gv[ai][m], v1 = acc[ai][bj][m][1] * gv[ai][m];
                    u32x4 w; w.x = pg::cvt_pk_bf16(v0[0], v0[1]); w.y = pg::cvt_pk_bf16(v0[2], v0[3]); w.z = pg::cvt_pk_bf16(v1[0], v1[1]); w.w = pg::cvt_pk_bf16(v1[2], v1[3]);
                    *(u32x4*)(rowp + bj * 128) = w; } }
    } };


typedef int i32x4_t __attribute__((ext_vector_type(4)));
typedef int i32x8_t __attribute__((ext_vector_type(8)));
struct F1Epi8 { unsigned char* hid; float ig, iu;
    __device__ __forceinline__ void operator()(const f32x4 (&acc)[2][4][2], int tile, int wr, int wc, int fr, int fq) const {
        const int i = tile >> 1, rh = tile & 1;
        asm volatile("" : "+v"(fr));
        const int row0 = rh * 128 + wr * 64 + fr, col0 = i * 128 + wc * 32 + 8 * fq;
#pragma unroll
        for (int m = 0; m < 4; ++m) { float h[8];
#pragma unroll
            for (int n = 0; n < 2; ++n)
#pragma unroll
                for (int j = 0; j < 4; ++j) { const float g = acc[0][m][n][j] * ig, u = acc[1][m][n][j] * iu; h[n * 4 + j] = __builtin_amdgcn_fmed3f(g * u * frcp(1.0f + fexp(-g)) * HID_SCALE, -448.f, 448.f); }
            u32x2 w;
            { int q8 = __builtin_amdgcn_cvt_pk_fp8_f32(h[0], h[1], 0, false); w.x = (unsigned)__builtin_amdgcn_cvt_pk_fp8_f32(h[2], h[3], q8, true); }
            { int q8 = __builtin_amdgcn_cvt_pk_fp8_f32(h[4], h[5], 0, false); w.y = (unsigned)__builtin_amdgcn_cvt_pk_fp8_f32(h[6], h[7], q8, true); }
            *(u32x2*)(hid + (size_t)(row0 + m * 16) * HIDPB + col0) = w; }
    } };
struct F2Tiles8 { const char* hid; const char* Wd; int x, sl, ntiles;
    __device__ __forceinline__ void get(int tile, const char*& a, const char*& b0, const char*& b1, bool& second) const { const int i = tile >> 1, rh = tile & 1;
        const int e = 4 * i + (x >> 1), b = 8 * (x & 1) + (sl >> 2), pn = sl & 3, be = b * 16 + e;
        a = hid + ((size_t)be * CAP + rh * 128) * HIDPB; b0 = Wd + ((size_t)e * D + pn * 256) * HIDPB; b1 = b0 + (size_t)128 * HIDPB; second = false; } };
struct F2Epi8 { bf16_t* Y; const float* gsel; const float* fsc; int x, sl;
    __device__ __forceinline__ void operator()(const f32x4 (&acc)[2][4][2], int tile, int wr, int wc, int fr, int fq) const {
        const int i = tile >> 1, rh = tile & 1;
        const int e = 4 * i + (x >> 1), b = 8 * (x & 1) + (sl >> 2), pn = sl & 3, be = b * 16 + e;
        asm volatile("" : "+v"(fr));
        const int row0 = rh * 128 + wr * 64 + fr, col0 = pn * 256 + wc * 32 + 8 * fq;
        const float inv = fsc[(32 + e) * 2 + 1] * (1.0f / HID_SCALE);
        float gv[4];
#pragma unroll
        for (int m = 0; m < 4; ++m) gv[m] = gsel[(size_t)be * CAP + row0 + m * 16] * inv;
#pragma unroll
        for (int m = 0; m < 4; ++m) { bf16_t* rowp = Y + ((size_t)be * CAP + row0 + m * 16) * D + col0;
#pragma unroll
            for (int bj = 0; bj < 2; ++bj) { const f32x4 v0 = acc[bj][m][0] * gv[m], v1 = acc[bj][m][1] * gv[m];
                u32x4 w; w.x = pg::cvt_pk_bf16(v0[0], v0[1]); w.y = pg::cvt_pk_bf16(v0[2], v0[3]); w.z = pg::cvt_pk_bf16(v1[0], v1[1]); w.w = pg::cvt_pk_bf16(v1[2], v1[3]);
                *(u32x4*)(rowp + bj * 128) = w; } }
    } };
struct F1Tiles8 { const char* A; const char* Wg; const char* Wu; int ntiles;
    __device__ __forceinline__ void get(int tile, const char*& a, const char*& b0, const char*& b1, bool& second) const { const int i = tile >> 1; a = A; b0 = Wg + (size_t)i * 128 * KPB; b1 = Wu + (size_t)i * 128 * KPB; second = (tile & 1) != 0; } };
template <int NK, class Tiles, class Epi>
__device__ __forceinline__ void gemm8(LAS unsigned char* lds, const Tiles& TS, const Epi& E, const unsigned (&voffA)[2][2], const unsigned (&voffB)[2]) {
    int tid = threadIdx.x; asm volatile("" : "+v"(tid));
    const int wid = __builtin_amdgcn_readfirstlane(tid >> 6), lane = tid & 63, wr = wid >> 2, wc = wid & 3, fr = lane & 15, fq = lane >> 4;
    const unsigned ldsw = (unsigned)wid * 1024u, ldsb = (unsigned)(unsigned long long)lds;
    const int aoff = pg::lds_byte(wr * 64 + fr, fq * 8), boff = pg::lds_byte(wc * 32 + fr, fq * 8);
    constexpr int LK = NK == 8 ? 3 : 4; static_assert(NK == 8 || NK == 16, "NK");
    const int NG = TS.ntiles * NK;
    constexpr unsigned RING = 49152u;
    const int one8 = 0x7F7F7F7F;
    unsigned va00 = voffA[0][0], va01 = voffA[0][1], va10 = voffA[1][0], va11 = voffA[1][1];
    asm volatile("" : "+v"(va00), "+v"(va01), "+v"(va10), "+v"(va11));
#define G8_ONE(ldsoff, gs, vo) do { unsigned keep_; const unsigned ld_ = (unsigned)__builtin_amdgcn_readfirstlane((int)(ldsb + (ldsoff) + ldsw)); \
        asm volatile("s_mov_b32 %0, m0\n\ts_mov_b32 m0, %3\n\ts_nop 0\n\tglobal_load_lds_dwordx4 %1, %2\n\ts_mov_b32 m0, %0" : "=&s"(keep_) : "v"(vo), "s"(gs), "s"(ld_) : "memory"); } while (0)
#define G8_DMA(ldsoff, gptr, v0, v1) do { const unsigned long long ga_ = (unsigned long long)(const char*)(gptr); \
        const unsigned long long gs_ = ((unsigned long long)(unsigned)__builtin_amdgcn_readfirstlane((unsigned)(ga_ >> 32)) << 32) | (unsigned long long)(unsigned)__builtin_amdgcn_readfirstlane((unsigned)ga_); \
        G8_ONE((ldsoff), gs_, v0); G8_ONE((ldsoff) + 8192u, gs_, v1); } while (0)
#define G8_STAGE(g_, rb_) do { const int tl_ = (g_) >> LK, kt_ = (g_) & (NK - 1); const char* a_; const char* b0_; const char* b1_; bool rh_; TS.get(tl_, a_, b0_, b1_, rh_); const unsigned bo_ = (unsigned)(rb_) * RING; \
        const unsigned va0_ = rh_ ? va10 : va00, va1_ = rh_ ? va11 : va01; \
        G8_DMA(bo_, a_ + kt_ * 128, va0_, va1_); G8_DMA(bo_ + 16384u, b0_ + kt_ * 128, voffB[0], voffB[1]); G8_DMA(bo_ + 32768u, b1_ + kt_ * 128, voffB[0], voffB[1]); } while (0)
#define G8_LD(off_) __builtin_shufflevector(*(const LAS i32x4_t*)(bp_ + (off_)), *(const LAS i32x4_t*)(bp_ + (off_) + 1024), 0, 1, 2, 3, 4, 5, 6, 7)
#define G8_READ(AS, GS, US, rb_) do { const LAS unsigned char* bp_ = lds + (unsigned)(rb_) * RING; \
        _Pragma("unroll") for (int n = 0; n < 2; ++n) { GS[n] = G8_LD(16384 + boff + n * 2048); US[n] = G8_LD(32768 + boff + n * 2048); } \
        _Pragma("unroll") for (int m = 0; m < 4; ++m) AS[m] = G8_LD(aoff + m * 2048); } while (0)
#define G8_MMA(AS, GS, US) do { __builtin_amdgcn_sched_barrier(0); __builtin_amdgcn_s_setprio(1); \
        _Pragma("unroll") for (int m = 0; m < 4; ++m) _Pragma("unroll") for (int n = 0; n < 2; ++n) {        \
            acc[0][m][n] = __builtin_amdgcn_mfma_scale_f32_16x16x128_f8f6f4(GS[n], AS[m], acc[0][m][n], 0, 0, 0, one8, 0, one8); \
            acc[1][m][n] = __builtin_amdgcn_mfma_scale_f32_16x16x128_f8f6f4(US[n], AS[m], acc[1][m][n], 0, 0, 0, one8, 0, one8); } \
        __builtin_amdgcn_s_setprio(0); __builtin_amdgcn_sched_barrier(0); } while (0)
#define G8_MROW(AS, GS, US, m) do { _Pragma("unroll") for (int n = 0; n < 2; ++n) {        \
            acc[0][m][n] = __builtin_amdgcn_mfma_scale_f32_16x16x128_f8f6f4(GS[n], AS[m], acc[0][m][n], 0, 0, 0, one8, 0, one8); \
            acc[1][m][n] = __builtin_amdgcn_mfma_scale_f32_16x16x128_f8f6f4(US[n], AS[m], acc[1][m][n], 0, 0, 0, one8, 0, one8); } __builtin_amdgcn_sched_barrier(0); } while (0)
#define G8_MMA_STAGE(AS, GS, US, g_, rb_) do { const int tl_ = (g_) >> LK, kt_ = (g_) & (NK - 1); const char* a_; const char* b0_; const char* b1_; bool rh_; TS.get(tl_, a_, b0_, b1_, rh_); const unsigned bo_ = (unsigned)(rb_) * RING; \
        const unsigned va0_ = rh_ ? va10 : va00, va1_ = rh_ ? va11 : va01; \
        __builtin_amdgcn_sched_barrier(0); G8_DMA(bo_, a_ + kt_ * 128, va0_, va1_); __builtin_amdgcn_sched_barrier(0); __builtin_amdgcn_s_setprio(1); \
        G8_MROW(AS, GS, US, 0); G8_MROW(AS, GS, US, 1); G8_DMA(bo_ + 16384u, b0_ + kt_ * 128, voffB[0], voffB[1]); \
        G8_MROW(AS, GS, US, 2); G8_DMA(bo_ + 32768u, b1_ + kt_ * 128, voffB[0], voffB[1]); \
        G8_MROW(AS, GS, US, 3); __builtin_amdgcn_s_setprio(0); __builtin_amdgcn_sched_barrier(0); } while (0)
#define G8_WAITV(n) asm volatile("s_waitcnt vmcnt(" #n ")" ::: "memory")
    f32x4 acc[2][4][2];
#pragma unroll
    for (int b = 0; b < 2; ++b)
#pragma unroll
        for (int m = 0; m < 4; ++m)
#pragma unroll
            for (int n = 0; n < 2; ++n) acc[b][m][n] = (f32x4){0.f, 0.f, 0.f, 0.f};
    i32x8_t A0[4], G0[2], U0[2], A1[4], G1[2], U1[2];
    G8_STAGE(0, 0); G8_STAGE(1, 1); G8_STAGE(2, 2);
    G8_WAITV(12); __builtin_amdgcn_s_barrier();
    G8_READ(A0, G0, U0, 0);
    asm volatile("s_waitcnt lgkmcnt(0)" ::: "memory");
    int bg = 0;
#pragma unroll 1
    for (int tile = 0; tile < TS.ntiles; ++tile) {
#pragma unroll 1
        for (int kk = 0; kk < NK; kk += 2) {
            const int g = tile * NK + kk;
            const int bg1 = bg == 2 ? 0 : bg + 1, bg2 = bg1 == 2 ? 0 : bg1 + 1;
            G8_WAITV(6);
            __builtin_amdgcn_s_barrier();
            __builtin_amdgcn_sched_barrier(0);
            G8_READ(A1, G1, U1, bg1);
            { const int gn_ = g + 3 < NG ? g + 3 : NG - 1; G8_MMA_STAGE(A0, G0, U0, gn_, bg); }
            asm volatile("s_waitcnt lgkmcnt(0)" ::: "memory");
            G8_WAITV(6);
            __builtin_amdgcn_s_barrier();
            __builtin_amdgcn_sched_barrier(0);
            G8_READ(A0, G0, U0, bg2);
            { const int gn_ = g + 4 < NG ? g + 4 : NG - 1; G8_MMA_STAGE(A1, G1, U1, gn_, bg1); }
            asm volatile("s_waitcnt lgkmcnt(0)" ::: "memory");
            bg = bg2;
        }
        E(acc, tile, wr, wc, fr, fq);
#pragma unroll
        for (int b = 0; b < 2; ++b)
#pragma unroll
            for (int m = 0; m < 4; ++m)
#pragma unroll
                for (int n = 0; n < 2; ++n) acc[b][m][n] = (f32x4){0.f, 0.f, 0.f, 0.f};
    }
    G8_WAITV(0);
    __builtin_amdgcn_s_barrier();
#undef G8_ONE
#undef G8_DMA
#undef G8_STAGE
#undef G8_LD
#undef G8_READ
#undef G8_MMA
#undef G8_WAITV
#undef G8_MROW
#undef G8_MMA_STAGE
}

__device__ __forceinline__ int inc9(int x, int d) { const int y = x + d; return y >= 9 ? y - 9 : y; }
template <int NK, class Tiles, class Epi>
__device__ __forceinline__ void gemm8w(LAS unsigned char* lds, const Tiles& TS, const Epi& E, const unsigned (&voffA)[2][2], const unsigned (&voffB)[2]) {
    int tid = threadIdx.x; asm volatile("" : "+v"(tid));
    const int wid = __builtin_amdgcn_readfirstlane(tid >> 6), lane = tid & 63, wr = wid >> 2, wc = wid & 3, fr = lane & 15, fq = lane >> 4;
    const unsigned ldsw = (unsigned)wid * 1024u, ldsb = (unsigned)(unsigned long long)lds;
    const int aoff = pg::lds_byte(wr * 64 + fr, fq * 8), boff = pg::lds_byte(wc * 32 + fr, fq * 8);
    constexpr int LK = NK == 8 ? 3 : 4; static_assert(NK == 8 || NK == 16, "NK");
    const int NG = TS.ntiles * NK;
    constexpr unsigned SLOT = 16384u;
    const int one8 = 0x7F7F7F7F;
    unsigned va00 = voffA[0][0], va01 = voffA[0][1], va10 = voffA[1][0], va11 = voffA[1][1], vb0 = voffB[0], vb1 = voffB[1];
    asm volatile("" : "+v"(va00), "+v"(va01), "+v"(va10), "+v"(va11), "+v"(vb0), "+v"(vb1));
#define W8_ONE(ldsoff, gs, vo) do { unsigned keep_; const unsigned ld_ = (unsigned)__builtin_amdgcn_readfirstlane((int)(ldsb + (ldsoff) + ldsw)); \
        asm volatile("s_mov_b32 %0, m0\n\ts_mov_b32 m0, %3\n\ts_nop 0\n\tglobal_load_lds_dwordx4 %1, %2\n\ts_mov_b32 m0, %0" : "=&s"(keep_) : "v"(vo), "s"(gs), "s"(ld_) : "memory"); } while (0)
#define W8_DMA(slot_, gptr, v0, v1) do { const unsigned long long ga_ = (unsigned long long)(const char*)(gptr); const unsigned so_ = (unsigned)(slot_) * SLOT; \
        const unsigned long long gs_ = ((unsigned long long)(unsigned)__builtin_amdgcn_readfirstlane((unsigned)(ga_ >> 32)) << 32) | (unsigned long long)(unsigned)__builtin_amdgcn_readfirstlane((unsigned)ga_); \
        W8_ONE(so_, gs_, v0); W8_ONE(so_ + 8192u, gs_, v1); } while (0)
#define W8_PIECE(q, g_, slot_) do { const int gg_ = (g_) < NG ? (g_) : NG - 1; const int tl_ = gg_ >> LK, kt_ = gg_ & (NK - 1); const char* a0_; const char* a1_; const char* b0_; const char* b1_; TS.get(tl_, a0_, a1_, b0_, b1_); \
        if ((q) == 0) W8_DMA(slot_, b0_ + kt_ * 128, vb0, vb1); else if ((q) == 1) W8_DMA(slot_, b1_ + kt_ * 128, vb0, vb1); \
        else if ((q) == 2) W8_DMA(slot_, a0_ + kt_ * 128, va00, va01); else W8_DMA(slot_, a1_ + kt_ * 128, va10, va11); } while (0)
#define W8_LD(base_, off_) __builtin_shufflevector(*(const LAS i32x4_t*)((base_) + (off_)), *(const LAS i32x4_t*)((base_) + (off_) + 1024), 0, 1, 2, 3, 4, 5, 6, 7)
#define W8_MROW(RH, m) do { _Pragma("unroll") for (int n = 0; n < 2; ++n) {        \
            acc[RH][0][m][n] = __builtin_amdgcn_mfma_scale_f32_16x16x128_f8f6f4(G8[n], A8[m], acc[RH][0][m][n], 0, 0, 0, one8, 0, one8); \
            acc[RH][1][m][n] = __builtin_amdgcn_mfma_scale_f32_16x16x128_f8f6f4(U8[n], A8[m], acc[RH][1][m][n], 0, 0, 0, one8, 0, one8); } __builtin_amdgcn_sched_barrier(0); } while (0)
#define W8_WAITV(n) asm volatile("s_waitcnt vmcnt(" #n ")" ::: "memory")
    f32x4 acc[2][2][4][2];
#pragma unroll
    for (int r = 0; r < 2; ++r)
#pragma unroll
        for (int b = 0; b < 2; ++b)
#pragma unroll
            for (int m = 0; m < 4; ++m)
#pragma unroll
                for (int n = 0; n < 2; ++n) acc[r][b][m][n] = (f32x4){0.f, 0.f, 0.f, 0.f};
    i32x8_t AX[4], AY[4], G8[2], U8[2];
    W8_PIECE(2, 0, 0); W8_PIECE(0, 0, 1); W8_PIECE(1, 0, 2); W8_PIECE(3, 0, 3);
    W8_PIECE(2, 1, 4); W8_PIECE(0, 1, 5); W8_PIECE(1, 1, 6); W8_PIECE(3, 1, 7);
    W8_PIECE(2, 2, 8);
    W8_WAITV(16); __builtin_amdgcn_s_barrier();
    {
#pragma unroll
        for (int m = 0; m < 4; ++m) AX[m] = W8_LD(lds, aoff + m * 2048); }
    asm volatile("s_waitcnt lgkmcnt(0)" ::: "memory");
    int s0 = 0;
#pragma unroll 1
    for (int tile = 0; tile < TS.ntiles; ++tile) {
#pragma unroll 1
        for (int kt = 0; kt < NK; ++kt) {
            const int g = tile * NK + kt;
            const int s1 = inc9(s0, 1), s2 = inc9(s0, 2), s3 = inc9(s0, 3), s4 = inc9(s0, 4);
            W8_WAITV(10);
            __builtin_amdgcn_s_barrier();
            __builtin_amdgcn_sched_barrier(0);
            { const LAS unsigned char* pg_ = lds + (unsigned)s1 * SLOT; const LAS unsigned char* pu_ = lds + (unsigned)s2 * SLOT; const LAS unsigned char* pa_ = lds + (unsigned)s3 * SLOT;
#pragma unroll
              for (int n = 0; n < 2; ++n) { G8[n] = W8_LD(pg_, boff + n * 2048); U8[n] = W8_LD(pu_, boff + n * 2048); }
#pragma unroll
              for (int m = 0; m < 4; ++m) AY[m] = W8_LD(pa_, aoff + m * 2048); }
            __builtin_amdgcn_sched_barrier(0);
#define A8 AX
            W8_MROW(0, 0); W8_PIECE(0, g + 2, s0); W8_MROW(0, 1); W8_MROW(0, 2); W8_MROW(0, 3);
#undef A8
            asm volatile("s_waitcnt lgkmcnt(0)" ::: "memory");
            W8_WAITV(10);
            __builtin_amdgcn_s_barrier();
            __builtin_amdgcn_sched_barrier(0);
            { const LAS unsigned char* pa_ = lds + (unsigned)s4 * SLOT;
#pragma unroll
              for (int m = 0; m < 4; ++m) AX[m] = W8_LD(pa_, aoff + m * 2048); }
            __builtin_amdgcn_sched_barrier(0);
#define A8 AY
            W8_MROW(1, 0); W8_PIECE(1, g + 2, s1); W8_MROW(1, 1); W8_PIECE(3, g + 2, s2); W8_MROW(1, 2); W8_PIECE(2, g + 3, s3); W8_MROW(1, 3);
#undef A8
            asm volatile("s_waitcnt lgkmcnt(0)" ::: "memory");
            s0 = s4;
        }
        E(acc, tile, wr, wc, fr, fq);
#pragma unroll
        for (int r = 0; r < 2; ++r)
#pragma unroll
            for (int b = 0; b < 2; ++b)
#pragma unroll
                for (int m = 0; m < 4; ++m)
#pragma unroll
                    for (int n = 0; n < 2; ++n) acc[r][b][m][n] = (f32x4){0.f, 0.f, 0.f, 0.f};
    }
    W8_WAITV(0);
    __builtin_amdgcn_s_barrier();
#undef W8_ONE
#undef W8_DMA
#undef W8_PIECE
#undef W8_LD
#undef W8_MROW
#undef W8_WAITV
}
struct F1Tiles8w { const char* A; const char* Wg; const char* Wu; int ntiles;
    __device__ __forceinline__ void get(int tile, const char*& a0, const char*& a1, const char*& b0, const char*& b1) const { a0 = A; a1 = A; b0 = Wg + (size_t)tile * 128 * KPB; b1 = Wu + (size_t)tile * 128 * KPB; } };
struct F1Epi8w { unsigned char* hid; float ig, iu;
    __device__ __forceinline__ void operator()(const f32x4 (&acc)[2][2][4][2], int i, int wr, int wc, int fr, int fq) const {
        asm volatile("" : "+v"(fr));
        const int row0 = wr * 64 + fr, col0 = i * 128 + wc * 32 + 8 * fq;
        const f32x2 c1 = (f32x2){-ig * 1.4426950408889634f, -ig * 1.4426950408889634f}, c2 = (f32x2){ig * iu * HID_SCALE, ig * iu * HID_SCALE}, one2 = (f32x2){1.0f, 1.0f};
#pragma unroll
        for (int rh = 0; rh < 2; ++rh)
#pragma unroll
            for (int m = 0; m < 4; ++m) { unsigned w[2];
#pragma unroll
                for (int n = 0; n < 2; ++n) { const f32x4 ga4 = acc[rh][0][m][n], ua4 = acc[rh][1][m][n]; f32x2 hp[2];
#pragma unroll
                    for (int p = 0; p < 2; ++p) { const f32x2 ga = p ? (f32x2){ga4.z, ga4.w} : (f32x2){ga4.x, ga4.y}, ua = p ? (f32x2){ua4.z, ua4.w} : (f32x2){ua4.x, ua4.y};
                        const f32x2 t = ga * c1; const f32x2 den = (f32x2){fexp2(t.x), fexp2(t.y)} + one2; const f32x2 sg = (f32x2){frcp(den.x), frcp(den.y)} * c2;
                        hp[p] = (ga * ua) * sg; }
                    const int q8 = __builtin_amdgcn_cvt_pk_fp8_f32(__builtin_amdgcn_fmed3f(hp[0].x, -448.f, 448.f), __builtin_amdgcn_fmed3f(hp[0].y, -448.f, 448.f), 0, false);
                    w[n] = (unsigned)__builtin_amdgcn_cvt_pk_fp8_f32(__builtin_amdgcn_fmed3f(hp[1].x, -448.f, 448.f), __builtin_amdgcn_fmed3f(hp[1].y, -448.f, 448.f), q8, true); }
                *(u32x2*)(hid + (size_t)(rh * 128 + row0 + m * 16) * HIDPB + col0) = (u32x2){w[0], w[1]}; }
    } };
struct F2Tiles8w { const char* hid; const char* Wd; int x, sl, ntiles;
    __device__ __forceinline__ void get(int tile, const char*& a0, const char*& a1, const char*& b0, const char*& b1) const {
        const int e = 4 * tile + (x >> 1), b = 8 * (x & 1) + (sl >> 2), pn = sl & 3, be = b * 16 + e;
        a0 = hid + (size_t)be * CAP * HIDPB; a1 = a0 + (size_t)128 * HIDPB; b0 = Wd + ((size_t)e * D + pn * 256) * HIDPB; b1 = b0 + (size_t)128 * HIDPB; } };
struct F2Epi8w { unsigned char* Y; const float* gsel; const float* fsc; int x, sl;
    __device__ __forceinline__ void operator()(const f32x4 (&acc)[2][2][4][2], int i, int wr, int wc, int fr, int fq) const {
        const int e = 4 * i + (x >> 1), b = 8 * (x & 1) + (sl >> 2), pn = sl & 3, be = b * 16 + e;
        asm volatile("" : "+v"(fr));
        const int row0 = wr * 64 + fr, col0 = pn * 256 + wc * 32 + 8 * fq;
        const float inv = fsc[(32 + e) * 2 + 1] * (Y_SCALE / HID_SCALE);
#pragma unroll
        for (int rh = 0; rh < 2; ++rh) { float gv[4];
#pragma unroll
            for (int m = 0; m < 4; ++m) gv[m] = gsel[(size_t)be * CAP + rh * 128 + row0 + m * 16] * inv;
#pragma unroll
            for (int m = 0; m < 4; ++m) { unsigned char* rowp = Y + ((size_t)be * CAP + rh * 128 + row0 + m * 16) * D + col0;
#pragma unroll
                for (int bj = 0; bj < 2; ++bj) { float h[8];
#pragma unroll
                    for (int n = 0; n < 2; ++n)
#pragma unroll
                        for (int j = 0; j < 4; ++j) h[n * 4 + j] = __builtin_amdgcn_fmed3f(acc[rh][bj][m][n][j] * gv[m], -448.f, 448.f);
                    u32x2 w;
                    { int q8 = __builtin_amdgcn_cvt_pk_fp8_f32(h[0], h[1], 0, false); w.x = (unsigned)__builtin_amdgcn_cvt_pk_fp8_f32(h[2], h[3], q8, true); }
                    { int q8 = __builtin_amdgcn_cvt_pk_fp8_f32(h[4], h[5], 0, false); w.y = (unsigned)__builtin_amdgcn_cvt_pk_fp8_f32(h[6], h[7], q8, true); }
                    *(u32x2*)(rowp + bj * 128) = w; } } }
    } };

struct F2TilesL { const char* hid; const char* Wd; int ntiles;
    __device__ __forceinline__ void get(int tile, const char*& a0, const char*& a1, const char*& b0, const char*& b1) const {
        a0 = hid; a1 = a0 + (size_t)128 * HIDPB; b0 = Wd + (size_t)(tile * 256) * HIDPB; b1 = b0 + (size_t)128 * HIDPB; } };
struct F2EpiL { unsigned char* Y; const float* gsel; float inv;
    __device__ __forceinline__ void operator()(const f32x4 (&acc)[2][2][4][2], int i, int wr, int wc, int fr, int fq) const {
        asm volatile("" : "+v"(fr));
        const int row0 = wr * 64 + fr, col0 = i * 256 + wc * 32 + 8 * fq;
#pragma unroll
        for (int rh = 0; rh < 2; ++rh) { float gv[4];
#pragma unroll
            for (int m = 0; m < 4; ++m) gv[m] = gsel[rh * 128 + row0 + m * 16] * inv;
#pragma unroll
            for (int m = 0; m < 4; ++m) { unsigned char* rowp = Y + (size_t)(rh * 128 + row0 + m * 16) * D + col0;
#pragma unroll
                for (int bj = 0; bj < 2; ++bj) { float h[8];
#pragma unroll
                    for (int n = 0; n < 2; ++n)
#pragma unroll
                        for (int j = 0; j < 4; ++j) h[n * 4 + j] = __builtin_amdgcn_fmed3f(acc[rh][bj][m][n][j] * gv[m], -448.f, 448.f);
                    u32x2 w;
                    { int q8 = __builtin_amdgcn_cvt_pk_fp8_f32(h[0], h[1], 0, false); w.x = (unsigned)__builtin_amdgcn_cvt_pk_fp8_f32(h[2], h[3], q8, true); }
                    { int q8 = __builtin_amdgcn_cvt_pk_fp8_f32(h[4], h[5], 0, false); w.y = (unsigned)__builtin_amdgcn_cvt_pk_fp8_f32(h[6], h[7], q8, true); }
                    *(u32x2*)(rowp + bj * 128) = w; } } }
    } };

struct TItem { const float* W; bf16_t* WT; int ldw, K, k0, src_n0, n0; float sc; };
__device__ __forceinline__ void titem_load(const TItem& t, f32x4 (&r)[8], int lane) {
#pragma unroll
    for (int i = 0; i < 8; ++i) { const int kk = 8 * i + (lane >> 3), n4 = (lane & 7) * 4; r[i] = __builtin_nontemporal_load((const f32x4*)(t.W + (size_t)(t.k0 + kk) * t.ldw + t.src_n0 + n4)); }
}
typedef short s16x4c __attribute__((ext_vector_type(4)));
__device__ __forceinline__ void titem_store(const TItem& t, const f32x4 (&r)[8], LAS unsigned char* scr, int lane) {
#pragma unroll
    for (int i = 0; i < 8; ++i) { const int kk = 8 * i + (lane >> 3); *(LAS u32x2*)(scr + kk * 96 + (lane & 7) * 8) = (u32x2){pk2(r[i].x, r[i].y), pk2(r[i].z, r[i].w)}; }
    asm volatile("" ::: "memory");
    const int fr = lane & 15, g = lane >> 4, q_ = fr >> 2, pp = fr & 3;
#pragma unroll
    for (int nb = 0; nb < 2; ++nb)
#pragma unroll
        for (int kh = 0; kh < 2; ++kh) { LAS unsigned char* p = scr + (32 * kh + 8 * g + q_) * 96 + nb * 32 + pp * 8;
            const s16x4c v0 = __builtin_amdgcn_ds_read_tr16_b64_v4i16((LAS s16x4c*)p), v1 = __builtin_amdgcn_ds_read_tr16_b64_v4i16((LAS s16x4c*)(p + 4 * 96));
            typedef short s16x8c __attribute__((ext_vector_type(8)));
            const s16x8c o = (s16x8c){v0[0], v0[1], v0[2], v0[3], v1[0], v1[1], v1[2], v1[3]};
            *(u32x4*)(t.WT + (size_t)(t.n0 + 16 * nb + fr) * t.K + t.k0 + 32 * kh + 8 * g) = __builtin_bit_cast(u32x4, o); }
    asm volatile("s_waitcnt lgkmcnt(0)" ::: "memory");
}
__device__ __forceinline__ void titem_load8(const TItem& t, f32x4 (&r)[8], int lane) {
    const unsigned lo = (unsigned)((lane >> 3) * 8 * t.ldw + (lane & 7) * 4);
    const float* bp = t.W + (size_t)t.k0 * t.ldw + t.src_n0;
#pragma unroll
    for (int i = 0; i < 8; ++i) { r[i] = __builtin_nontemporal_load((const f32x4*)(bp + lo)); bp += t.ldw; }
}
__device__ __forceinline__ void titem_store8n(const TItem& t, const f32x4 (&r)[8], int lane) {
    unsigned char* dst = (unsigned char*)t.WT + (size_t)(t.n0 + (lane & 7) * 4) * t.K + t.k0 + 8 * (lane >> 3);
    f32x4 v[8];
#pragma unroll
    for (int i = 0; i < 8; ++i) v[i] = r[i] * t.sc;
#pragma unroll
    for (int c = 0; c < 4; ++c) {
        int w0 = __builtin_amdgcn_cvt_pk_fp8_f32(__builtin_amdgcn_fmed3f(v[0][c], -448.f, 448.f), __builtin_amdgcn_fmed3f(v[1][c], -448.f, 448.f), 0, false);
        w0 = __builtin_amdgcn_cvt_pk_fp8_f32(__builtin_amdgcn_fmed3f(v[2][c], -448.f, 448.f), __builtin_amdgcn_fmed3f(v[3][c], -448.f, 448.f), w0, true);
        int w1 = __builtin_amdgcn_cvt_pk_fp8_f32(__builtin_amdgcn_fmed3f(v[4][c], -448.f, 448.f), __builtin_amdgcn_fmed3f(v[5][c], -448.f, 448.f), 0, false);
        w1 = __builtin_amdgcn_cvt_pk_fp8_f32(__builtin_amdgcn_fmed3f(v[6][c], -448.f, 448.f), __builtin_amdgcn_fmed3f(v[7][c], -448.f, 448.f), w1, true);
        *(u32x2*)(dst + (size_t)c * t.K) = (u32x2){(unsigned)w0, (unsigned)w1}; }
}
__device__ __forceinline__ TItem p0_item(const MkArgs& a, int it) {
    unsigned char* ws = a.ws; TItem t;
    constexpr int I_IN = 16 * 80, I_OUT = 16 * 32, I_GE = 16 * 64, I_DE = 32 * 32;
    int r = it;
    if (r < I_IN) { const int kb = r / 80, nb = r % 80, n0 = nb * 32; t.W = a.in[5]; t.ldw = PROJ_TOTAL; t.K = KP; t.k0 = kb * 64; t.src_n0 = n0 < 1024 ? n0 : n0 + 16; t.WT = (bf16_t*)(ws + WS_WIN); t.n0 = n0; t.sc = 0.f; return t; } r -= I_IN;
    if (r < I_OUT) { const int kb = r / 32, nb = r % 32; t.W = a.in[18]; t.ldw = D; t.K = KP; t.k0 = kb * 64; t.src_n0 = nb * 32; t.WT = (bf16_t*)(ws + WS_WOUT); t.n0 = nb * 32; t.sc = 0.f; return t; } r -= I_OUT;
    if (r < 16 * I_GE) { const int e = r / I_GE, q = r % I_GE, kb = q / 64, nb = q % 64; t.W = a.in[22] + (size_t)e * D * DFF; t.ldw = DFF; t.K = KPB; t.k0 = kb * 64; t.src_n0 = nb * 32; t.WT = (bf16_t*)(ws + WS_WG + (size_t)e * DFF * KPB); t.n0 = nb * 32; t.sc = ((const float*)(ws + WS_FSC))[(2 * e) * 2]; return t; } r -= 16 * I_GE;
    if (r < 16 * I_GE) { const int e = r / I_GE, q = r % I_GE, kb = q / 64, nb = q % 64; t.W = a.in[23] + (size_t)e * D * DFF; t.ldw = DFF; t.K = KPB; t.k0 = kb * 64; t.src_n0 = nb * 32; t.WT = (bf16_t*)(ws + WS_WU + (size_t)e * DFF * KPB); t.n0 = nb * 32; t.sc = ((const float*)(ws + WS_FSC))[(2 * e + 1) * 2]; return t; } r -= 16 * I_GE;
    { const int e = r / I_DE, q = r % I_DE, kb = q / 32, nb = q % 32; t.W = a.in[24] + (size_t)e * DFF * D; t.ldw = D; t.K = HIDPB; t.k0 = kb * 64; t.src_n0 = nb * 32; t.WT = (bf16_t*)(ws + WS_WD + (size_t)e * D * HIDPB); t.n0 = nb * 32; t.sc = ((const float*)(ws + WS_FSC))[(32 + e) * 2]; return t; }
}
__device__ __forceinline__ void p0_phase(const MkArgs& a, LAS unsigned char* lds, int G, int bx, int tid, int lane, int wave) {
    unsigned char* ws = a.ws;
    float* mod = (float*)(ws + WS_MOD);
    if (bx < 192) {
        const float* cc = a.in[1]; const float* w_ada = a.in[2]; const float* b_ada = a.in[3];
        LAS float* red = (LAS float*)lds;
        const int n0 = bx * 32, bq = lane & 15, ks = lane >> 4;
        f32x4 av[8]; float bv0[32], bv1[32];
        const float* cp = cc + bq * 1024 + 128 * wave + 32 * ks;
#pragma unroll
        for (int i = 0; i < 8; ++i) av[i] = *(const f32x4*)(cp + 4 * i);
        const float* wp = w_ada + (size_t)(128 * wave + 32 * ks) * 6144 + n0 + bq;
#pragma unroll
        for (int sidx = 0; sidx < 32; ++sidx) { bv0[sidx] = wp[(size_t)sidx * 6144]; bv1[sidx] = wp[(size_t)sidx * 6144 + 16]; }
        f32x4 acc0 = (f32x4){0.f, 0.f, 0.f, 0.f}, acc1 = (f32x4){0.f, 0.f, 0.f, 0.f};
#pragma unroll
        for (int sidx = 0; sidx < 32; ++sidx) { const float sv = silu_f(av[sidx >> 2][sidx & 3]);
            acc0 = __builtin_amdgcn_mfma_f32_16x16x4f32(sv, bv0[sidx], acc0, 0, 0, 0); acc1 = __builtin_amdgcn_mfma_f32_16x16x4f32(sv, bv1[sidx], acc1, 0, 0, 0); }
        *(LAS f32x4*)(red + ((wave * 2 + 0) * 64 + lane) * 4) = acc0; *(LAS f32x4*)(red + ((wave * 2 + 1) * 64 + lane) * 4) = acc1;
        __syncthreads();
        {   const int t = tid >> 8, l = (tid >> 2) & 63, r = tid & 3; float sum = 0.f;
#pragma unroll
            for (int w = 0; w < 8; ++w) sum += red[((w * 2 + t) * 64 + l) * 4 + r];
            const int n = n0 + 16 * t + (l & 15), bb = 4 * (l >> 4) + r; mod[bb * 6144 + n] = sum + b_ada[n]; }
    }
    if (bx < 48) {
        const float* Wsm = bx < 32 ? a.in[22 + (bx & 1)] + (size_t)(bx >> 1) * D * DFF : a.in[24] + (size_t)(bx - 32) * DFF * D;
        LAS float* mred = (LAS float*)lds + 8192;
        float mx = 0.f;
#pragma unroll
        for (int i = 0; i < 16; ++i) { const f32x4 v = *(const f32x4*)(Wsm + (size_t)(i * 512 + tid) * 4); mx = fmaxf(fmaxf(mx, fmaxf(fabsf(v.x), fabsf(v.y))), fmaxf(fabsf(v.z), fabsf(v.w))); }
#pragma unroll
        for (int o = 1; o < 64; o <<= 1) mx = fmaxf(mx, __shfl_xor(mx, o));
        if (lane == 0) mred[wave] = mx;
        __syncthreads();
        if (tid == 0) { float m8 = 0.f; for (int w = 0; w < 8; ++w) m8 = fmaxf(m8, mred[w]);
            int ex = (int)((__float_as_uint(m8) >> 23) & 255u) - 127; if (!(m8 > 0.f)) ex = 5; ex = ex < -100 ? -100 : (ex > 100 ? 100 : ex);
            float* fsc = (float*)(ws + WS_FSC); fsc[bx * 2] = __uint_as_float((unsigned)(127 + 5 - ex) << 23); fsc[bx * 2 + 1] = __uint_as_float((unsigned)(127 - 5 + ex) << 23); }
    }
    if (bx == G - 1) {
        float* bt = (float*)(ws + WS_BIAS); const float* rel_bias = a.in[17];
        for (int i = tid; i < 3 * 8 * 129; i += 512) { const int p = i / (8 * 129), h = (i / 129) % 8, r = i % 129; const int dil = p == 0 ? 1 : (p == 1 ? 4 : 16);
            bt[(p * 8 + h) * 132 + r] = rel_bias[t5_bucket((r - 64) * dil) * 8 + h]; }
    }
}

__device__ __forceinline__ float reduce16(float (&v)[16], int lane) {
    float a8[8], a4[4], a2[2];
    const bool h5 = lane & 32, h4 = lane & 16, h3 = lane & 8, h2 = lane & 4;
#pragma unroll
    for (int i = 0; i < 8; ++i) { const float send = h5 ? v[i] : v[i + 8], keep = h5 ? v[i + 8] : v[i]; a8[i] = keep + __shfl_xor(send, 32); }
#pragma unroll
    for (int i = 0; i < 4; ++i) { const float send = h4 ? a8[i] : a8[i + 4], keep = h4 ? a8[i + 4] : a8[i]; a4[i] = keep + __shfl_xor(send, 16); }
#pragma unroll
    for (int i = 0; i < 2; ++i) { const float send = h3 ? a4[i] : a4[i + 2], keep = h3 ? a4[i + 2] : a4[i]; a2[i] = keep + __shfl_xor(send, 8); }
    float r; { const float send = h2 ? a2[0] : a2[1], keep = h2 ? a2[1] : a2[0]; r = keep + __shfl_xor(send, 4); }
    r += __shfl_xor(r, 1); r += __shfl_xor(r, 2);
    return r;
}
template <int MODE>
__device__ __forceinline__ void norm_phase(const MkArgs& a, LAS unsigned char* lds, int G, int bx, int tid, int lane, int wave) {
    unsigned char* ws = a.ws;
    constexpr int WP = 1028;
    LAS float* Wt = (LAS float*)lds; LAS float* mulL = Wt + 16 * WP; LAS float* addL = mulL + 1024; LAS float* cqL = addL + 1024; LAS float* red = cqL + 16; LAS float* exL = red + 512;
    const int b = (bx * 128) / S;
    const float* gvec = MODE == 0 ? a.in[4] : a.in[19];
    const float* mod = (const float*)(ws + WS_MOD) + b * 6144 + (MODE == 0 ? 0 : 3072);
    const float* xin = a.in[0]; const bf16_t* mixp = (const bf16_t*)(ws + WS_MIX);
    bf16_t* hB = (bf16_t*)(ws + WS_HB);
    int tz = threadIdx.x; asm volatile("" : "+v"(tz));
    tid = tz; lane = tz & 63; wave = __builtin_amdgcn_readfirstlane(tz >> 6);
    const int r = lane & 15, g = lane >> 4, qf = wave & 3, pr = wave >> 2;
    const int cb = 256 * qf + 16 * g;
    constexpr int NSET = MODE == 0 ? 2 : 1;
    f32x4 xr[NSET][4][4]; u32x4 mr[NSET][4][2];
#define NP_LOAD(st_, kb_, m_) do { const float* xp_ = xin + (size_t)(m_) * D + cb + 64 * (kb_); \
        xr[st_][kb_][0] = *(const f32x4*)(xp_); xr[st_][kb_][1] = *(const f32x4*)(xp_ + 4); xr[st_][kb_][2] = *(const f32x4*)(xp_ + 8); xr[st_][kb_][3] = *(const f32x4*)(xp_ + 12); \
        if (MODE == 1) { const bf16_t* mp_ = mixp + (size_t)(m_) * D + cb + 64 * (kb_); mr[st_][kb_][0] = *(const u32x4*)(mp_); mr[st_][kb_][1] = *(const u32x4*)(mp_ + 8); } } while (0)
    {   const int mf = (bx * 8 + pr) * 16 + r;
#pragma unroll
        for (int kb = 0; kb < 4; ++kb) NP_LOAD(0, kb, mf);
#pragma unroll
        for (int kb = 0; kb < 4; ++kb) if (NSET == 2) NP_LOAD(NSET - 1, kb, mf + 32); }
    TItem wt_; f32x4 wreg_[8]; const bool wdo_ = MODE == 0 && (bx * 8 + wave) < 16 * 80 + 16 * 32;
    if (wdo_) { wt_ = p0_item(a, bx * 8 + wave); titem_load(wt_, wreg_, lane); }
    if (MODE == 0) { const float* w_in = a.in[5];
#pragma unroll 8
        for (int i = tid; i < 16 * 1024; i += 512) { const int k = i >> 4, q = i & 15; Wt[q * WP + k] = w_in[(size_t)k * PROJ_TOTAL + 1024 + q]; } }
    else { const float* w_r = a.in[20];
#pragma unroll 8
        for (int i = tid; i < 16 * 1024; i += 512) { const int k = i >> 4, q = i & 15; Wt[q * WP + k] = w_r[i]; } }
    for (int k = tid; k < 1024; k += 512) { mulL[k] = gvec[k] * (1.0f + mod[1024 + k]); addL[k] = mod[k]; }
    __syncthreads();
    { const int q = tid & 15, part = tid >> 4; float sacc = 0.f;
      for (int k = part * 32; k < part * 32 + 32; ++k) sacc += addL[k] * Wt[q * WP + k];
      red[part * 16 + q] = sacc; }
    __syncthreads();
    if (tid < 16) { float sacc = 0.f; for (int p = 0; p < 32; ++p) sacc += red[p * 16 + tid]; cqL[tid] = sacc; }
    __syncthreads();
#pragma unroll
    for (int rd = 0; rd < 4; ++rd) {
        const int m0 = (bx * 8 + pr + 2 * rd) * 16, m = m0 + r;
        if (MODE == 1) {
#pragma unroll
            for (int kb = 0; kb < 4; ++kb) {
#pragma unroll
                for (int hh = 0; hh < 2; ++hh) { const u32x4 mm = mr[rd % NSET][kb][hh];
                    xr[rd % NSET][kb][2 * hh].x += __uint_as_float(mm.x << 16); xr[rd % NSET][kb][2 * hh].y += __uint_as_float(mm.x & 0xffff0000u); xr[rd % NSET][kb][2 * hh].z += __uint_as_float(mm.y << 16); xr[rd % NSET][kb][2 * hh].w += __uint_as_float(mm.y & 0xffff0000u);
                    xr[rd % NSET][kb][2 * hh + 1].x += __uint_as_float(mm.z << 16); xr[rd % NSET][kb][2 * hh + 1].y += __uint_as_float(mm.z & 0xffff0000u); xr[rd % NSET][kb][2 * hh + 1].z += __uint_as_float(mm.w << 16); xr[rd % NSET][kb][2 * hh + 1].w += __uint_as_float(mm.w & 0xffff0000u); }
#pragma unroll
                for (int j = 0; j < 2; ++j) { const f32x4 p0 = xr[rd % NSET][kb][2 * j], p1 = xr[rd % NSET][kb][2 * j + 1];
                    *(u32x4*)((bf16_t*)(ws + WS_X1B) + (size_t)m * D + cb + 64 * kb + 8 * j) = (u32x4){pk2(p0.x, p0.y), pk2(p0.z, p0.w), pk2(p1.x, p1.y), pk2(p1.z, p1.w)}; }
            }
        }
        f32x4 acc = (f32x4){0.f, 0.f, 0.f, 0.f}; float ss = 0.f;
#pragma unroll
        for (int kb = 0; kb < 4; ++kb) {
            asm volatile("" ::: "memory");
            const int kc = cb + 64 * kb;
#pragma unroll
            for (int j = 0; j < 4; ++j) { const f32x4 mu = *(const LAS f32x4*)(mulL + kc + 4 * j), wv = *(const LAS f32x4*)(Wt + r * WP + kc + 4 * j);
#pragma unroll
                for (int i = 0; i < 4; ++i) { const float xx = xr[rd % NSET][kb][j][i]; ss += xx * xx; acc = __builtin_amdgcn_mfma_f32_16x16x4f32(xx * mu[i], wv[i], acc, 0, 0, 0); } }
        }
        ss += __shfl_xor(ss, 16); ss += __shfl_xor(ss, 32);
        {   LAS float* exw = exL + (((rd & 1) * 8 + wave) * 64 + lane) * 5; exw[0] = ss; exw[1] = acc[0]; exw[2] = acc[1]; exw[3] = acc[2]; exw[4] = acc[3]; }
        __syncthreads();
        float val;
        {   const LAS float* exr = exL + (((rd & 1) * 8 + 4 * pr) * 64 + lane) * 5;
            ss = (exr[0] + exr[320]) + (exr[640] + exr[960]);
            val = (exr[1 + qf] + exr[320 + 1 + qf]) + (exr[640 + 1 + qf] + exr[960 + 1 + qf]); }
        const float rinv = rsqrtf(ss * (1.0f / D) + EPS);
        val = val * __shfl(rinv, 4 * g + qf) + cqL[r];
        if (MODE == 0) {
            const float* b_ig = a.in[11]; const float* b_fg = a.in[12];
            const int grp = r >> 2, hh = r & 3; float o;
            if (grp == 0) o = val + b_ig[hh]; else if (grp == 1) o = log_sigmoid_f(val + b_fg[hh]); else if (grp == 2) o = val + b_ig[4 + hh]; else o = log_sigmoid_f(val + b_fg[4 + hh]);
            ((float*)(ws + WS_GATES))[(size_t)(m0 + 4 * g + qf) * 16 + r] = o;
        } else {
            const float lg = val + a.in[21][r]; float mx = lg;
#pragma unroll
            for (int o = 1; o < 16; o <<= 1) mx = fmaxf(mx, __shfl_xor(mx, o));
            const float ex = expf(lg - mx); float sum = ex;
#pragma unroll
            for (int o = 1; o < 16; o <<= 1) sum += __shfl_xor(sum, o);
            const int mm = m0 + 4 * g + qf;
            ((float*)(ws + WS_AFF))[(size_t)((mm >> 11) * 16 + r) * S + (mm & 2047)] = ex / sum;
        }
        bf16_t* hrow = hB + (size_t)m * KP + cb; unsigned char* h8row = (unsigned char*)hB + (size_t)m * KPB + cb;
#pragma unroll
        for (int kb = 0; kb < 4; ++kb) { const int kc = cb + 64 * kb; unsigned w[8];
            asm volatile("" ::: "memory");
#pragma unroll
            for (int j = 0; j < 4; ++j) { const f32x4 xx = xr[rd % NSET][kb][j], mu = *(const LAS f32x4*)(mulL + kc + 4 * j), ad = *(const LAS f32x4*)(addL + kc + 4 * j);
                const float h0 = xx.x * rinv * mu.x + ad.x, h1 = xx.y * rinv * mu.y + ad.y, h2v = xx.z * rinv * mu.z + ad.z, h3 = xx.w * rinv * mu.w + ad.w;
                if (MODE == 0) { w[2 * j] = pk2(h0, h1); w[2 * j + 1] = pk2(h2v, h3); }
                else { int q8 = __builtin_amdgcn_cvt_pk_fp8_f32(__builtin_amdgcn_fmed3f(h0, -448.f, 448.f), __builtin_amdgcn_fmed3f(h1, -448.f, 448.f), 0, false);
                       w[j] = (unsigned)__builtin_amdgcn_cvt_pk_fp8_f32(__builtin_amdgcn_fmed3f(h2v, -448.f, 448.f), __builtin_amdgcn_fmed3f(h3, -448.f, 448.f), q8, true); } }
            if (MODE == 0) { *(u32x4*)(hrow + 64 * kb) = (u32x4){w[0], w[1], w[2], w[3]}; *(u32x4*)(hrow + 64 * kb + 8) = (u32x4){w[4], w[5], w[6], w[7]}; }
            else *(u32x4*)(h8row + 64 * kb) = (u32x4){w[0], w[1], w[2], w[3]};
            if (rd + NSET < 4) NP_LOAD(rd % NSET, kb, m + 32 * NSET); }
    }
    if (wdo_) titem_store(wt_, wreg_, lds + 110592 + wave * 6144, lane);
#undef NP_LOAD
}
__device__ __forceinline__ void topk_select(const float* aff, LAS unsigned* scr, LAS int* idxs, LAS float* gsl, float* gselg, unsigned short* inv, int tid, int lane, int wave) {
    LAS unsigned* hist = scr; LAS unsigned* selv = scr + 256; LAS unsigned* wtot = scr + 264;
    const f32x4 v = *(const f32x4*)(aff + 4 * tid);
    const unsigned key[4] = {__float_as_uint(v.x), __float_as_uint(v.y), __float_as_uint(v.z), __float_as_uint(v.w)};
    unsigned prefix = 0u, krem = 256u;
#pragma unroll
    for (int pass = 0; pass < 4; ++pass) {
        const int sh = 24 - 8 * pass; const unsigned himask = pass == 0 ? 0u : (0xFFFFFFFFu << (sh + 8));
        if (pass == 0) { if (tid < 256) hist[tid] = 0u; __syncthreads(); }
#pragma unroll
        for (int i = 0; i < 4; ++i) if ((key[i] & himask) == prefix) __hip_atomic_fetch_add(&hist[(key[i] >> sh) & 255u], 1u, __ATOMIC_RELAXED, __HIP_MEMORY_SCOPE_WORKGROUP);
        __syncthreads();
        if (wave == 0) {
            const u32x4 c4 = *(const LAS u32x4*)(hist + 4 * lane); *(LAS u32x4*)(hist + 4 * lane) = (u32x4){0u, 0u, 0u, 0u};
            const unsigned c0 = c4.x, c1 = c4.y, c2 = c4.z, c3 = c4.w, tot = c0 + c1 + c2 + c3;
            unsigned suf = tot;
#pragma unroll
            for (int o = 1; o < 64; o <<= 1) { const unsigned t = __shfl_down(suf, o); if (lane + o < 64) suf += t; }
            const unsigned a3 = suf - tot, a2 = a3 + c3, a1 = a2 + c2, a0 = a1 + c1;
            int bin = -1; unsigned ab = 0u;
            if (a3 < krem && krem <= a3 + c3) { bin = 3; ab = a3; }
            else if (a2 < krem && krem <= a2 + c2) { bin = 2; ab = a2; }
            else if (a1 < krem && krem <= a1 + c1) { bin = 1; ab = a1; }
            else if (a0 < krem && krem <= a0 + c0) { bin = 0; ab = a0; }
            if (bin >= 0) { selv[0] = prefix | ((unsigned)(4 * lane + bin) << sh); selv[1] = krem - ab; }
        }
        __syncthreads();
        prefix = selv[0]; krem = selv[1];
    }
    const unsigned T = prefix, ngt = 256u - krem;
    bool gt[4], eq[4]; unsigned cg = 0u, ce = 0u;
#pragma unroll
    for (int i = 0; i < 4; ++i) { gt[i] = key[i] > T; eq[i] = key[i] == T; cg += gt[i] ? 1u : 0u; ce += eq[i] ? 1u : 0u; }
    const unsigned packed = cg | (ce << 16);
    unsigned inc = packed;
#pragma unroll
    for (int o = 1; o < 64; o <<= 1) { const unsigned t = __shfl_up(inc, o); if (lane >= o) inc += t; }
    if (lane == 63) wtot[wave] = inc;
    __syncthreads();
    unsigned base = inc - packed;
#pragma unroll
    for (int w = 0; w < 8; ++w) if (w < wave) base += wtot[w];
    unsigned pgt = base & 0xffffu, peq = base >> 16, iv[4];
#pragma unroll
    for (int i = 0; i < 4; ++i) { int slot = -1;
        if (gt[i]) { slot = (int)pgt; ++pgt; } else if (eq[i]) { if (peq < krem) slot = (int)(ngt + peq); ++peq; }
        if (slot >= 0) { const float val = __uint_as_float(key[i]); idxs[slot] = 4 * tid + i; gsl[slot] = val; gselg[slot] = val; }
        iv[i] = slot >= 0 ? (unsigned)slot : 0xFFFFu; }
    *(u32x2*)(inv + 4 * tid) = (u32x2){iv[0] | (iv[1] << 16), iv[2] | (iv[3] << 16)};
    __syncthreads();
}
typedef short s16x4 __attribute__((ext_vector_type(4)));
constexpr float LOG2E = 1.4426950408889634f;
__device__ __forceinline__ int att_stage_token(int su, int half, int i) {
    const int p = su >> 3, k = su & 7;
    if (p == 0) { int pos = 1024 * half + 128 * k - 64 + i; pos = pos < 0 ? 0 : (pos > 2047 ? 2047 : pos); return pos; }
    if (p == 1) { int pos = 256 * half + 128 * (k & 1) - 64 + i; pos = pos < 0 ? 0 : (pos > 511 ? 511 : pos); return pos * 4 + (k >> 1); }
    return (i & 127) * 16 + 2 * k + (i >> 7);
}
__device__ __forceinline__ int att_tokq(int su, int half, int lane, int wave) {
    const int p = su >> 3, k = su & 7, fr = lane & 15;
    if (p == 0) return 1024 * half + 128 * k + 16 * wave + fr;
    if (p == 1) return (256 * half + 128 * (k & 1) + 16 * wave + fr) * 4 + (k >> 1);
    return (64 * half + 16 * (wave & 3) + fr) * 16 + 2 * k + (wave >> 2);
}
__device__ __forceinline__ void att_issue(const bf16_t* AQ, const bf16_t* AK, const bf16_t* AV, int su, int half, int tid, int lane, int wave, u32x4 (&kreg)[4], u32x4 (&vreg)[4], u32x4 (&qreg)[2]) {
    const int c = tid & 7;
    { const int tokq = att_tokq(su, half, lane, wave), g = lane >> 4; qreg[0] = *(const u32x4*)(AQ + (size_t)tokq * PP + 8 * g); qreg[1] = *(const u32x4*)(AQ + (size_t)tokq * PP + 32 + 8 * g); }
#pragma unroll
    for (int k = 0; k < 4; ++k) { const int i = (tid >> 3) + 64 * k; const size_t off = (size_t)att_stage_token(su, half, i) * PP + 8 * c;
        kreg[k] = *(const u32x4*)(AK + off); vreg[k] = *(const u32x4*)(AV + off); }
}
__device__ __forceinline__ void att_write(LAS unsigned char* Ks, LAS unsigned char* Vs, int tid, const u32x4 (&kreg)[4], const u32x4 (&vreg)[4]) {
    const int c = tid & 7;
#pragma unroll
    for (int k = 0; k < 4; ++k) { const int i = (tid >> 3) + 64 * k;
        *(LAS u32x4*)(Ks + i * 128 + ((c ^ (i & 7)) << 4)) = kreg[k];
        *(LAS u32x4*)(Vs + i * 128 + ((((c >> 1) ^ ((i >> 1) & 3))) << 5) + ((c & 1) << 4)) = vreg[k]; }
}
__device__ __forceinline__ void att_compute(const u32x4 (&qreg)[2], bf16_t* YA, float* LSE, LAS unsigned char* Ks, LAS unsigned char* Vs, const LAS float* biasL, int su, int half, int lane, int wave, bool cdo, const TItem& ct, f32x4 (&creg)[8]) {
    const int p = su >> 3, k = su & 7, fr = lane & 15, g = lane >> 4;
    int dil, L, r_w, pq0, pos_lo, rowbase;
    if (p == 0) { dil = 1; L = 2048; r_w = 0; pos_lo = 1024 * half + 128 * k - 64; pq0 = pos_lo + 64 + 16 * wave; rowbase = 0; }
    else if (p == 1) { dil = 4; L = 512; r_w = k >> 1; pos_lo = 256 * half + 128 * (k & 1) - 64; pq0 = pos_lo + 64 + 16 * wave; rowbase = 0; }
    else { dil = 16; L = 128; r_w = 2 * k + (wave >> 2); pos_lo = 0; pq0 = 64 * half + 16 * (wave & 3); rowbase = (wave >> 2) * 128; }
    const int tokq = (pq0 + fr) * dil + r_w;
    bf16x8 qf[2];
    bf16_t* yrow = YA + (size_t)tokq * KP + 4 * g; float* lp = LSE + (size_t)tokq * 8;
    float lprev = 0.f; unsigned long long pvv[4] = {0ull, 0ull, 0ull, 0ull};
    if (p > 0) { lprev = __hip_atomic_load(lp, __ATOMIC_RELAXED, __HIP_MEMORY_SCOPE_AGENT);
#pragma unroll
        for (int dt = 0; dt < 4; ++dt) pvv[dt] = __hip_atomic_load((unsigned long long*)(yrow + 16 * dt), __ATOMIC_RELAXED, __HIP_MEMORY_SCOPE_AGENT); }
    if (cdo) titem_load8(ct, creg, lane);
    qf[0] = __builtin_bit_cast(bf16x8, qreg[0]); qf[1] = __builtin_bit_cast(bf16x8, qreg[1]);
    f32x4 st[9]; int trow[10]; bool tval[9];
#pragma unroll
    for (int n = 0; n < 9; ++n) { const int pos_n = pq0 - 64 + 16 * n; tval[n] = (pos_n >= 0) && (pos_n < L); trow[n] = rowbase + (tval[n] ? pos_n - pos_lo : 0); }
    trow[9] = trow[8];
    const int kl0 = fr * 128 + ((g ^ (fr & 7)) << 4);
#pragma unroll
    for (int n = 0; n < 9; ++n) { const LAS unsigned char* kp = Ks + trow[n] * 128;
        const bf16x8 a0 = *(const LAS bf16x8*)(kp + kl0), a1 = *(const LAS bf16x8*)(kp + (kl0 ^ 64));
        f32x4 z = (f32x4){0.f, 0.f, 0.f, 0.f};
        z = __builtin_amdgcn_mfma_f32_16x16x32_bf16(a0, qf[0], z, 0, 0, 0);
        st[n] = __builtin_amdgcn_mfma_f32_16x16x32_bf16(a1, qf[1], z, 0, 0, 0); }
    const LAS float* bl = biasL + p * 160 + 16 + 4 * g - fr; const LAS float* blinv = biasL + 3 * 160 + 16 + 4 * g - fr;
    f32x2 ls2 = (f32x2){0.f, 0.f};
#pragma unroll
    for (int n = 0; n < 9; ++n) { const LAS float* bn = tval[n] ? bl + 16 * n : blinv;
        const f32x2 s01 = (f32x2){st[n][0], st[n][1]} + (f32x2){bn[0], bn[1]}, s23 = (f32x2){st[n][2], st[n][3]} + (f32x2){bn[2], bn[3]};
        const f32x2 e01 = (f32x2){fexp2(s01.x), fexp2(s01.y)}, e23 = (f32x2){fexp2(s23.x), fexp2(s23.y)};
        ls2 += e01; ls2 += e23; st[n] = (f32x4){e01.x, e01.y, e23.x, e23.y}; }
    float lsum = ls2.x + ls2.y;
    lsum += __shfl_xor(lsum, 16); lsum += __shfl_xor(lsum, 32);
    bf16x8 pf[5];
#pragma unroll
    for (int s2 = 0; s2 < 5; ++s2) { u32x4 w; w.x = pk2(st[2 * s2][0], st[2 * s2][1]); w.y = pk2(st[2 * s2][2], st[2 * s2][3]);
        if (s2 < 4) { w.z = pk2(st[2 * s2 + 1][0], st[2 * s2 + 1][1]); w.w = pk2(st[2 * s2 + 1][2], st[2 * s2 + 1][3]); } else { w.z = 0u; w.w = 0u; }
        pf[s2] = __builtin_bit_cast(bf16x8, w); }
    f32x4 oacc[4];
    const int q_ = fr >> 2, pp = fr & 3;
    const int vl0 = (4 * g + q_) * 128 + ((((4 * g + q_) >> 1) & 3) << 5) + 8 * pp;
#pragma unroll
    for (int dt = 0; dt < 4; ++dt) { oacc[dt] = (f32x4){0.f, 0.f, 0.f, 0.f};
#pragma unroll
        for (int s2 = 0; s2 < 5; ++s2) {
            const s16x4 v0 = __builtin_amdgcn_ds_read_tr16_b64_v4i16((LAS s16x4*)(Vs + trow[2 * s2] * 128 + (vl0 ^ (dt << 5))));
            const s16x4 v1 = __builtin_amdgcn_ds_read_tr16_b64_v4i16((LAS s16x4*)(Vs + trow[2 * s2 + 1] * 128 + (vl0 ^ (dt << 5))));
            const bf16x8 va = (bf16x8){v0[0], v0[1], v0[2], v0[3], v1[0], v1[1], v1[2], v1[3]};
            oacc[dt] = __builtin_amdgcn_mfma_f32_16x16x32_bf16(va, pf[s2], oacc[dt], 0, 0, 0); } }
    if (p > 0) lsum += lprev;
    const float sc_ = (p == 2) ? frcp(lsum) : 1.0f;
#pragma unroll
    for (int dt = 0; dt < 4; ++dt) { float o[4];
#pragma unroll
        for (int r = 0; r < 4; ++r) o[r] = oacc[dt][r];
        if (p > 0) { const unsigned long long pv = pvv[dt]; const unsigned lo = (unsigned)pv, hi = (unsigned)(pv >> 32);
            o[0] += __uint_as_float(lo << 16); o[1] += __uint_as_float(lo & 0xffff0000u); o[2] += __uint_as_float(hi << 16); o[3] += __uint_as_float(hi & 0xffff0000u); }
        *(uint2*)(yrow + 16 * dt) = make_uint2(pk2(o[0] * sc_, o[1] * sc_), pk2(o[2] * sc_, o[3] * sc_)); }
    if (g == 0 && p < 2) *lp = lsum;
}
__device__ __forceinline__ void attn_unit(const MkArgs& a, LAS unsigned char* lds, int u, int conv_base, int conv_n, int conv_split, int tid, int lane, int wave) {
    unsigned char* ws = a.ws;
    const int b = u >> 4, hd = (u >> 1) & 7, half = u & 1;
    const bf16_t* AQ = (const bf16_t*)(ws + WS_AQ) + (size_t)b * S * PP + hd * 64; const bf16_t* AK = (const bf16_t*)(ws + WS_AK) + (size_t)b * S * PP + hd * 64; const bf16_t* AV = (const bf16_t*)(ws + WS_AV) + (size_t)b * S * PP + hd * 64;
    bf16_t* YA = (bf16_t*)(ws + WS_YCAT) + (size_t)b * S * KP + 512 + hd * 64; float* LSE = (float*)(ws + WS_LSE) + (size_t)b * S * 8 + hd;
    LAS float* biasL = (LAS float*)(lds + 131072);
    const float* bt = (const float*)(ws + WS_BIAS);
    float shift;
    { float gqm = 0.f, gkm = 0.f, bm = 0.f;
      for (int d = 0; d < 64; ++d) { gqm = fmaxf(gqm, fabsf(a.in[15][d])); gkm = fmaxf(gkm, fabsf(a.in[16][d])); }
      for (int k = 0; k < 32; ++k) bm = fmaxf(bm, fabsf(a.in[17][k * 8 + hd]));
      shift = LOG2E * (8.0f * gqm * gkm + bm); }
    for (int i = tid; i < 4 * 160; i += 512) { const int p = i / 160, r = i % 160 - 16; biasL[i] = (p < 3 && r >= 0 && r <= 128) ? bt[(p * 8 + hd) * 132 + r] * LOG2E - shift : -INFINITY; }
    u32x4 kreg[4], vreg[4], qreg[2], qcur[2];
    att_issue(AQ, AK, AV, 0, half, tid, lane, wave, kreg, vreg, qreg);
    TItem ct; f32x4 creg[8];
    bool cdo = 0 < conv_n;
    if (cdo) { ct = p0_item(a, 16 * 80 + 16 * 32 + conv_base); titem_load8(ct, creg, lane); }
#pragma unroll 1
    for (int su = 0; su < 24; ++su) {
        LAS unsigned char* Ks = lds + (su & 1) * 65536; LAS unsigned char* Vs = Ks + 32768;
        att_write(Ks, Vs, tid, kreg, vreg);
        qcur[0] = qreg[0]; qcur[1] = qreg[1];
        __syncthreads();
        if (su + 1 < 24) att_issue(AQ, AK, AV, su + 1, half, tid, lane, wave, kreg, vreg, qreg);
        att_compute(qcur, YA, LSE, Ks, Vs, biasL, su, half, lane, wave, false, ct, creg);
        if (cdo) titem_store8n(ct, creg, lane);
        cdo = su + 1 < conv_n;
        if (cdo) { ct = p0_item(a, 16 * 80 + 16 * 32 + conv_base + 1024 * (su + 1) + ((conv_split && su + 1 >= 8) ? 12288 : 0)); titem_load8(ct, creg, lane); }
    }
    __syncthreads();
}


__device__ __forceinline__ int swz256(int row, int ch) { return 256 * row + 16 * (ch ^ (((row & 3) << 2) | ((row >> 2) & 3))); }
constexpr int ML_XC = 0, ML_QP = 16384, ML_VV = 32768, ML_PM = 49152, ML_SC = 57344;
__device__ __forceinline__ void mlstm_unit(const MkArgs& a, LAS unsigned char* lds, int u, int tid, int lane, int wave) {
    unsigned char* ws = a.ws;
    const int b = u >> 3, h = (u >> 1) & 3, dir = u & 1;
    const bf16_t* XM = (const bf16_t*)(ws + WS_XM) + (size_t)b * S * PP + h * 128;
    const bf16_t* OP = (const bf16_t*)(ws + WS_OPRE) + (size_t)b * S * PP + h * 128;
    const float* gates = (const float*)(ws + WS_GATES) + (size_t)b * S * 16;
    unsigned char* HFmine = (dir ? (unsigned char*)a.out : (unsigned char*)(ws + WS_HB)) + (size_t)(u >> 1) * (512 * 1024);
    unsigned char* HFpart = (dir ? (unsigned char*)(ws + WS_HB) : (unsigned char*)a.out) + (size_t)(u >> 1) * (512 * 1024);
    const __amdgpu_buffer_rsrc_t rs_mine = __builtin_amdgcn_make_buffer_rsrc(HFmine, 0, 512 * 1024, 0x00020000);
    const __amdgpu_buffer_rsrc_t rs_part = __builtin_amdgcn_make_buffer_rsrc(HFpart, 0, 512 * 1024, 0x00020000);
    unsigned* prog_mine = (unsigned*)(ws + WS_CTL) + 131072 + 64 * u; unsigned* prog_part = (unsigned*)(ws + WS_CTL) + 131072 + 64 * (u ^ 1);
    bf16_t* YM = (bf16_t*)(ws + WS_YCAT) + (size_t)b * S * KP + h * 128;
    LAS float* sc = (LAS float*)(lds + ML_SC);
    LAS float* cL = sc, *mmL = sc + 64, *emtL = sc + 128, *wiL = sc + 192, *wL = sc + 256, *rs = sc + 320, *qnL = sc + 576, *nL = sc + 640, *nred = sc + 768, *ssq = sc + 1792, *misc = sc + 2304;
#define ML_LANES() int lz_ = lane; asm volatile("" : "+v"(lz_)); const int fr = lz_ & 15, g = lz_ >> 4, q_ = fr >> 2, pp = fr & 3; (void)q_; (void)pp; (void)g; (void)fr
    LAS float* constL = sc + 2432;
    if (tid < 32) { const int cgi = h * 128 + 4 * tid, ggi = cgi >> 2; LAS float* cd = constL + tid * 56;
      const float* conv_w = a.in[6]; const float* conv_b = a.in[7]; const float* wq = a.in[8] + ggi * 16; const float* wk = a.in[9] + ggi * 16; const float* wv = a.in[10] + ggi * 16;
      for (int i = 0; i < 4; ++i) { cd[20 + i] = conv_b[cgi + i];
          for (int w = 0; w < 5; ++w) cd[w * 4 + i] = conv_w[w * 512 + cgi + i];
          for (int ip = 0; ip < 4; ++ip) { float mm = 0.f;
              for (int j = 0; j < 4; ++j) mm += wq[i * 4 + j] * wk[ip * 4 + j];
              cd[24 + i * 4 + ip] = mm * 0.08838834764831845f; cd[40 + i * 4 + ip] = wv[i * 4 + ip]; } } }
    const float ng = a.in[13][h * 128 + 16 * wave + (lane & 15)], sk = a.in[14][h * 128 + 16 * wave + (lane & 15)];
    LAS float* gB = (LAS float*)(lds + 81920); LAS float* gC = gB + 2048; LAS float* gP = gC + 2048; LAS float* gS = gP + 2048;
    for (int ci = wave; ci < 32; ci += 8) { const int cch = dir ? 31 - ci : ci, tok = cch * 64 + (dir ? 63 - lane : lane);
        const float ig = gates[(size_t)tok * 16 + (dir ? 8 : 0) + h], lf = gates[(size_t)tok * 16 + (dir ? 12 : 4) + h];
        float bb = lf;
#pragma unroll
        for (int o = 1; o < 64; o <<= 1) { const float v = __shfl_up(bb, o); if (lane >= o) bb += v; }
        const float cc = ig - bb; float pm = cc;
#pragma unroll
        for (int o = 1; o < 64; o <<= 1) { const float v = __shfl_up(pm, o); if (lane >= o) pm = fmaxf(pm, v); }
        gB[ci * 64 + lane] = bb; gC[ci * 64 + lane] = cc; gP[ci * 64 + lane] = pm;
        if (lane == 63) { gS[2 * ci] = bb; gS[2 * ci + 1] = pm; } }
    u32x2 xmr[8];
#define ML_PREFETCH(cc) do { int tz_ = tid; asm volatile("" : "+v"(tz_)); const int g4p = tz_ & 31, tqp = tz_ >> 5; const int tbp = (cc) * 64; \
        _Pragma("unroll") for (int r = 0; r < 8; ++r) { const int tk = tbp + 4 * tqp - 2 + r; u32x2 w2 = (u32x2){0u, 0u}; if (tk >= 0 && tk < S) w2 = *(const u32x2*)(XM + (size_t)tk * PP + 4 * g4p); xmr[r] = w2; } \
        } while (0)
    {
        ML_PREFETCH(dir ? 31 : 0);
        f32x4 Cacc[8];
#pragma unroll
        for (int dt = 0; dt < 8; ++dt) Cacc[dt] = (f32x4){0.f, 0.f, 0.f, 0.f};
        for (int i = tid; i < 2048; i += 512) ((LAS unsigned*)(lds + ML_PM))[i] = 0u;
        if (tid < 256) rs[tid] = 0.f;
        if (tid < 128) nL[tid] = 0.f;
        if (tid == 0) { misc[0] = 0.f; misc[1] = 1.f; }
        __syncthreads();
        for (int ci = 0; ci < 32; ++ci) {
            const int c = dir ? 31 - ci : ci, tb = c * 64;
            TItem ct; f32x4 creg[8]; const bool cdo = ci < 12;
            if (cdo) { ct = p0_item(a, 16 * 80 + 16 * 32 + 32768 + (u * 8 + wave) + 1024 * ci); titem_load8(ct, creg, lane); }
            { int tz_ = tid; asm volatile("" : "+v"(tz_)); const int g4 = tz_ & 31, tq = tz_ >> 5;
              f32x2 xm2[8][2], cw2[5][2], cb2[2], Mq2[4][2], Wv2[4][2];
              { const LAS f32x4* cd = (const LAS f32x4*)(constL + g4 * 56);
#pragma unroll
                for (int w = 0; w < 5; ++w) { const f32x4 t4 = cd[w]; cw2[w][0] = (f32x2){t4.x, t4.y}; cw2[w][1] = (f32x2){t4.z, t4.w}; }
                { const f32x4 t4 = cd[5]; cb2[0] = (f32x2){t4.x, t4.y}; cb2[1] = (f32x2){t4.z, t4.w}; }
#pragma unroll
                for (int i = 0; i < 4; ++i) { const f32x4 t4 = cd[6 + i], t5 = cd[10 + i]; Mq2[i][0] = (f32x2){t4.x, t4.y}; Mq2[i][1] = (f32x2){t4.z, t4.w}; Wv2[i][0] = (f32x2){t5.x, t5.y}; Wv2[i][1] = (f32x2){t5.z, t5.w}; } }
#pragma unroll
              for (int r = 0; r < 8; ++r) { const u32x2 wv2 = xmr[r];
                  xm2[r][0] = (f32x2){__uint_as_float(wv2.x << 16), __uint_as_float(wv2.x & 0xffff0000u)}; xm2[r][1] = (f32x2){__uint_as_float(wv2.y << 16), __uint_as_float(wv2.y & 0xffff0000u)}; }
              const f32x2 nl2e = (f32x2){-1.4426950408889634f, -1.4426950408889634f}, one2 = (f32x2){1.0f, 1.0f};
#pragma unroll
              for (int tl = 0; tl < 4; ++tl) { float xc[4]; float qv[4], vv[4];
                  f32x2 a2[2];
#pragma unroll
                  for (int p = 0; p < 2; ++p) { f32x2 acc = cb2[p];
#pragma unroll
                      for (int w = 0; w < 5; ++w) acc = __builtin_elementwise_fma(cw2[w][p], xm2[tl + w][p], acc);
                      const f32x2 t = acc * nl2e; const f32x2 den = (f32x2){fexp2(t.x), fexp2(t.y)} + one2;
                      a2[p] = acc * (f32x2){frcp(den.x), frcp(den.y)}; }
                  xc[0] = a2[0].x; xc[1] = a2[0].y; xc[2] = a2[1].x; xc[3] = a2[1].y;
                  const f32x2 xs0 = xm2[tl + 2][0], xs1 = xm2[tl + 2][1];
#pragma unroll
                  for (int pp = 0; pp < 2; ++pp) {
                      f32x2 q2 = (f32x2){xc[0], xc[0]} * Mq2[0][pp]; q2 = __builtin_elementwise_fma((f32x2){xc[1], xc[1]}, Mq2[1][pp], q2); q2 = __builtin_elementwise_fma((f32x2){xc[2], xc[2]}, Mq2[2][pp], q2); q2 = __builtin_elementwise_fma((f32x2){xc[3], xc[3]}, Mq2[3][pp], q2);
                      f32x2 v2 = (f32x2){xs0.x, xs0.x} * Wv2[0][pp]; v2 = __builtin_elementwise_fma((f32x2){xs0.y, xs0.y}, Wv2[1][pp], v2); v2 = __builtin_elementwise_fma((f32x2){xs1.x, xs1.x}, Wv2[2][pp], v2); v2 = __builtin_elementwise_fma((f32x2){xs1.y, xs1.y}, Wv2[3][pp], v2);
                      qv[2 * pp] = q2.x; qv[2 * pp + 1] = q2.y; vv[2 * pp] = v2.x; vv[2 * pp + 1] = v2.y; }
                  const int tloc = 4 * tq + tl, row = dir ? 63 - tloc : tloc; const int off = swz256(row, g4 >> 1) + 8 * (g4 & 1);
                  *(LAS u32x2*)(lds + ML_XC + off) = (u32x2){pk2(xc[0], xc[1]), pk2(xc[2], xc[3])};
                  *(LAS u32x2*)(lds + ML_QP + off) = (u32x2){pk2(qv[0], qv[1]), pk2(qv[2], qv[3])};
                  *(LAS u32x2*)(lds + ML_VV + off) = (u32x2){pk2(vv[0], vv[1]), pk2(vv[2], vv[3])}; } }
            if (wave == 0) {
                const float cc = gC[ci * 64 + lane], pm = gP[ci * 64 + lane], bb = gB[ci * 64 + lane], gtot = gS[2 * ci], amax = gtot + gS[2 * ci + 1];
                const float mprev = misc[0]; const float mnew = fmaxf(gtot + mprev, amax), mm = fmaxf(mprev, pm);
                cL[lane] = cc; mmL[lane] = mm; emtL[lane] = fexp(-(bb + mm)); wiL[lane] = fexp(mprev - mm); wL[lane] = fexp(gtot + cc - mnew);
                if (lane == 0) { misc[2] = mnew; misc[1] = fexp(gtot + mprev - mnew); }
            }
            if (ci + 1 < 32) ML_PREFETCH(dir ? 30 - ci : ci + 1);
            if (ci >= 16 && tid == 64) {
                const unsigned need = 32u - (unsigned)ci; unsigned spins = 0;
                while (__hip_atomic_load(prog_part, __ATOMIC_RELAXED, __HIP_MEMORY_SCOPE_AGENT) < need) { __builtin_amdgcn_s_sleep(2); if (++spins > (1u << 22)) break; } }
            __syncthreads();
            float hfr[16], opr[16];
            if (ci >= 16) { ML_LANES();
                const bf16_t* op0_ = OP + (size_t)(tb + (dir ? 63 - 4 * g : 4 * g)) * PP + 16 * wave + fr;
#pragma unroll
                for (int tt = 0; tt < 4; ++tt)
#pragma unroll
                    for (int r = 0; r < 4; ++r) opr[tt * 4 + r] = bf2f(op0_[(dir ? -(16 * tt + r) : (16 * tt + r)) * PP]);
            }
            {
                ML_LANES();
#pragma unroll
                for (int tt = 0; tt < 4; ++tt) { const unsigned off = (unsigned)((((((31 - ci) & 15) * 8 + wave) * 4 + (3 - tt)) * 64 + fr + 16 * (3 - g)) * 16);
                    const u32x4 hv = __builtin_amdgcn_raw_buffer_load_b128(rs_part, off, 0, 16);
                    hfr[tt * 4 + 0] = __uint_as_float(hv.w); hfr[tt * 4 + 1] = __uint_as_float(hv.z); hfr[tt * 4 + 2] = __uint_as_float(hv.y); hfr[tt * 4 + 3] = __uint_as_float(hv.x); } }
            { ML_LANES();
#pragma unroll
              for (int jj = 0; jj < 2; ++jj) {
                  const int jt = jj == 0 ? (int)((0xD980u >> (2 * wave)) & 3u) : wave, tt = jj == 0 ? (int)((0xF9F8u >> (2 * wave)) & 3u) : wave + 1;
                  if (jj == 0 || wave < 2) { f32x4 z = (f32x4){0.f, 0.f, 0.f, 0.f};
                      const int rj = 16 * jt + fr, rt = 16 * tt + fr;
                      const int xf = ((fr & 3) << 2) | ((fr >> 2) & 3), cb_ = 256 * fr + 16 * (g ^ (xf & 3));
#pragma unroll
                      for (int s4 = 0; s4 < 4; ++s4) { const int co = cb_ + ((s4 ^ (xf >> 2)) << 6);
                          const bf16x8 av = *(const LAS bf16x8*)(lds + ML_XC + 4096 * jt + co), bv = *(const LAS bf16x8*)(lds + ML_QP + 4096 * tt + co);
                          z = __builtin_amdgcn_mfma_f32_16x16x32_bf16(av, bv, z, 0, 0, 0); }
                      const float mmt = mmL[rt]; float pv[4], psum = 0.f;
#pragma unroll
                      for (int r = 0; r < 4; ++r) { const int j = 16 * jt + 4 * g + r; const float e = (j <= rt) ? fexp(cL[j] - mmt) * z[r] : 0.f; pv[r] = e; psum += e; }
                      psum += __shfl_xor(psum, 16); psum += __shfl_xor(psum, 32);
                      if (g == 0) rs[jt * 64 + rt] = psum;
                      *(LAS u32x2*)(lds + ML_PM + rt * 128 + (((2 * jt + (g >> 1)) ^ (rt & 7)) << 4) + 8 * (g & 1)) = (u32x2){pk2(pv[0], pv[1]), pk2(pv[2], pv[3])}; } } }
            { int tz_ = tid; asm volatile("" : "+v"(tz_)); const int t = tz_ >> 3, part = tz_ & 7; f32x2 aq2 = (f32x2){0.f, 0.f};
#define ML_BF2(x) (f32x2){__uint_as_float((x) << 16), __uint_as_float((x) & 0xffff0000u)}
#pragma unroll
              for (int hh = 0; hh < 2; ++hh) { const u32x4 qv = *(const LAS u32x4*)(lds + ML_QP + swz256(t, 2 * part + hh)); const f32x4 n0 = *(const LAS f32x4*)(nL + 16 * part + 8 * hh), n1 = *(const LAS f32x4*)(nL + 16 * part + 8 * hh + 4);
                  aq2 = __builtin_elementwise_fma(ML_BF2(qv.x), (f32x2){n0.x, n0.y}, aq2); aq2 = __builtin_elementwise_fma(ML_BF2(qv.y), (f32x2){n0.z, n0.w}, aq2);
                  aq2 = __builtin_elementwise_fma(ML_BF2(qv.z), (f32x2){n1.x, n1.y}, aq2); aq2 = __builtin_elementwise_fma(ML_BF2(qv.w), (f32x2){n1.z, n1.w}, aq2); }
              float accq = aq2.x + aq2.y;
              accq += __shfl_xor(accq, 1); accq += __shfl_xor(accq, 2); accq += __shfl_xor(accq, 4);
              if (part == 0) qnL[t] = accq; }
            if (wave >= 2) { int tz_ = tid; asm volatile("" : "+v"(tz_)); const int dp = tz_ & 63;
#pragma unroll
              for (int pz = 0; pz < 2; ++pz) { const int lq = pz == 0 ? wave : wave - 2;
                  if (pz == 0 || wave < 4) { f32x2 sn2 = (f32x2){0.f, 0.f};
#pragma unroll
                      for (int i = 0; i < 8; ++i) { const int l = 8 * lq + i; const unsigned xv = *(const LAS unsigned*)(lds + ML_XC + swz256(l, dp >> 2) + 4 * (dp & 3)); const float w = wL[l];
                          sn2 = __builtin_elementwise_fma((f32x2){w, w}, ML_BF2(xv), sn2); }
                      *(LAS f32x2*)(nred + lq * 128 + 2 * dp) = sn2; } } }
#undef ML_BF2
            if (cdo) titem_store8n(ct, creg, lane);
            __syncthreads();
            const float decay = misc[1];
            ML_LANES();
            f32x4 hacc[4];
            { bf16x8 Cb[4];
#pragma unroll
              for (int s4 = 0; s4 < 4; ++s4) { u32x4 w; w.x = pg::cvt_pk_bf16(Cacc[2 * s4][0], Cacc[2 * s4][1]); w.y = pg::cvt_pk_bf16(Cacc[2 * s4][2], Cacc[2 * s4][3]); w.z = pg::cvt_pk_bf16(Cacc[2 * s4 + 1][0], Cacc[2 * s4 + 1][1]); w.w = pg::cvt_pk_bf16(Cacc[2 * s4 + 1][2], Cacc[2 * s4 + 1][3]); Cb[s4] = __builtin_bit_cast(bf16x8, w); }
              const int xfi = ((fr & 3) << 2) | ((fr >> 2) & 3), ib_ = 256 * fr + 16 * ((g >> 1) ^ (xfi & 3)) + 8 * (g & 1);
#pragma unroll
              for (int tt = 0; tt < 4; ++tt) { f32x4 z = (f32x4){0.f, 0.f, 0.f, 0.f};
                  if (tt == 2) asm volatile("" ::: "memory");
#pragma unroll
                  for (int s4 = 0; s4 < 4; ++s4) { const int io = ib_ + ((s4 ^ (xfi >> 2)) << 6);
                      const u32x2 lo = *(const LAS u32x2*)(lds + ML_QP + 4096 * tt + io), hi = *(const LAS u32x2*)(lds + ML_QP + 4096 * tt + (io ^ 32));
                      const u32x4 w = (u32x4){lo.x, lo.y, hi.x, hi.y};
                      z = __builtin_amdgcn_mfma_f32_16x16x32_bf16(__builtin_bit_cast(bf16x8, w), Cb[s4], z, 0, 0, 0); }
                  const f32x4 wi = *(const LAS f32x4*)(wiL + 16 * tt + 4 * g);
                  hacc[tt] = z * wi; } }
            bf16x8 Vb[2];
            const int rl0 = (8 * g + q_) & 15, rl1 = (8 * g + q_ + 4) & 15;
            const int xt0 = ((rl0 & 3) << 2) | ((rl0 >> 2) & 3), xt1 = ((rl1 & 3) << 2) | ((rl1 >> 2) & 3);
            const int tr0 = 256 * (8 * g + q_) + 8 * (pp & 1), tr1 = tr0 + 1024;
#pragma unroll
            for (int s2 = 0; s2 < 2; ++s2) {
                const s16x4 v0 = __builtin_amdgcn_ds_read_tr16_b64_v4i16((LAS s16x4*)(lds + ML_VV + 8192 * s2 + tr0 + 16 * ((2 * wave + (pp >> 1)) ^ xt0)));
                const s16x4 v1 = __builtin_amdgcn_ds_read_tr16_b64_v4i16((LAS s16x4*)(lds + ML_VV + 8192 * s2 + tr1 + 16 * ((2 * wave + (pp >> 1)) ^ xt1)));
                Vb[s2] = (bf16x8){v0[0], v0[1], v0[2], v0[3], v1[0], v1[1], v1[2], v1[3]}; }
#pragma unroll
            for (int tt = 0; tt < 4; ++tt) { const int rt = 16 * tt + fr;
#pragma unroll
                for (int s2 = 0; s2 < 2; ++s2) { const bf16x8 pa = *(const LAS bf16x8*)(lds + ML_PM + rt * 128 + (((4 * s2 + g) ^ (rt & 7)) << 4));
                    hacc[tt] = __builtin_amdgcn_mfma_f32_16x16x32_bf16(pa, Vb[s2], hacc[tt], 0, 0, 0); } }
            { const int taum = 16 * (fr >> 2) + 4 * g + (fr & 3);
              const float den = wiL[taum] * qnL[taum] + ((rs[taum] + rs[64 + taum]) + (rs[128 + taum] + rs[192 + taum]));
              const float rdm = frcp(fmaxf(fabsf(den), emtL[taum]));
#pragma unroll
              for (int tt = 0; tt < 4; ++tt)
#pragma unroll
                  for (int r = 0; r < 4; ++r) hacc[tt][r] *= __shfl(rdm, (lane & 48) + 4 * tt + r); }
            if (ci < 16) {
#pragma unroll
                for (int tt = 0; tt < 4; ++tt) { const unsigned off = (unsigned)((((ci * 8 + wave) * 4 + tt) * 64 + lane) * 16);
                    __builtin_amdgcn_raw_buffer_store_b128((u32x4){__float_as_uint(hacc[tt][0]), __float_as_uint(hacc[tt][1]), __float_as_uint(hacc[tt][2]), __float_as_uint(hacc[tt][3])}, rs_mine, off, 0, 16); }
            } else {
                float v16[16];
#pragma unroll
                for (int tt = 0; tt < 4; ++tt)
#pragma unroll
                    for (int r = 0; r < 4; ++r) { hacc[tt][r] += hfr[tt * 4 + r]; v16[tt * 4 + r] = hacc[tt][r] * hacc[tt][r]; }
                float a8[8], a4[4], a2[2];
                const bool h3 = lane & 8, h2 = lane & 4, h1 = lane & 2, h0 = lane & 1;
#pragma unroll
                for (int i = 0; i < 8; ++i) { const float send = h3 ? v16[i] : v16[i + 8], keep = h3 ? v16[i + 8] : v16[i]; a8[i] = keep + __shfl_xor(send, 8); }
#pragma unroll
                for (int i = 0; i < 4; ++i) { const float send = h2 ? a8[i] : a8[i + 4], keep = h2 ? a8[i + 4] : a8[i]; a4[i] = keep + __shfl_xor(send, 4); }
#pragma unroll
                for (int i = 0; i < 2; ++i) { const float send = h1 ? a4[i] : a4[i + 2], keep = h1 ? a4[i + 2] : a4[i]; a2[i] = keep + __shfl_xor(send, 2); }
                float tot; { const float send = h0 ? a2[0] : a2[1], keep = h0 ? a2[1] : a2[0]; tot = keep + __shfl_xor(send, 1); }
                ssq[wave * 64 + 16 * (fr >> 2) + 4 * g + (fr & 3)] = tot;
            }
            { bf16x8 Wb[2];
#pragma unroll
              for (int s2 = 0; s2 < 2; ++s2) { const f32x4 w0 = *(const LAS f32x4*)(wL + 32 * s2 + 8 * g), w1 = *(const LAS f32x4*)(wL + 32 * s2 + 8 * g + 4); u32x4 o;
                  const u32x4 vb = __builtin_bit_cast(u32x4, Vb[s2]);
                  o.x = pk2(__uint_as_float(vb.x << 16) * w0.x, __uint_as_float(vb.x & 0xffff0000u) * w0.y); o.y = pk2(__uint_as_float(vb.y << 16) * w0.z, __uint_as_float(vb.y & 0xffff0000u) * w0.w);
                  o.z = pk2(__uint_as_float(vb.z << 16) * w1.x, __uint_as_float(vb.z & 0xffff0000u) * w1.y); o.w = pk2(__uint_as_float(vb.w << 16) * w1.z, __uint_as_float(vb.w & 0xffff0000u) * w1.w);
                  Wb[s2] = __builtin_bit_cast(bf16x8, o); }
#pragma unroll
              for (int dt = 0; dt < 8; ++dt) { Cacc[dt] = Cacc[dt] * decay;
                  const int xo0 = tr0 + 16 * ((2 * dt + (pp >> 1)) ^ xt0), xo1 = tr1 + 16 * ((2 * dt + (pp >> 1)) ^ xt1);
#pragma unroll
                  for (int s2 = 0; s2 < 2; ++s2) {
                      const s16x4 x0 = __builtin_amdgcn_ds_read_tr16_b64_v4i16((LAS s16x4*)(lds + ML_XC + 8192 * s2 + xo0));
                      const s16x4 x1 = __builtin_amdgcn_ds_read_tr16_b64_v4i16((LAS s16x4*)(lds + ML_XC + 8192 * s2 + xo1));
                      const bf16x8 xa = (bf16x8){x0[0], x0[1], x0[2], x0[3], x1[0], x1[1], x1[2], x1[3]};
                      Cacc[dt] = __builtin_amdgcn_mfma_f32_16x16x32_bf16(xa, Wb[s2], Cacc[dt], 0, 0, 0); } } }
            if (tid < 128) { float sN = 0.f;
#pragma unroll
                for (int qq = 0; qq < 8; ++qq) sN += nred[qq * 128 + tid];
                nL[tid] = decay * nL[tid] + sN; }
            if (tid == 0) misc[0] = misc[2];
            if (ci >= 16) {
                __syncthreads();
                float rimine; { const int taum = 16 * (fr >> 2) + 4 * g + (fr & 3); float s2 = 0.f;
#pragma unroll
                    for (int w8 = 0; w8 < 8; ++w8) s2 += ssq[w8 * 64 + taum];
                    rimine = rsqrtf(s2 * (1.0f / 128) + EPS); }
                bf16_t* yp0_ = YM + (size_t)(tb + (dir ? 63 - 4 * g : 4 * g)) * KP + 16 * wave + fr;
#pragma unroll
                for (int tt = 0; tt < 4; ++tt)
#pragma unroll
                    for (int rp = 0; rp < 2; ++rp) { const int e = 16 * wave + fr;
                        const int tau0 = 16 * tt + 4 * g + 2 * rp, tau1 = tau0 + 1; const int tau0r = 16 * tt + 2 * rp;
                        const f32x2 ri2 = (f32x2){__shfl(rimine, (lane & 48) + 4 * tt + 2 * rp), __shfl(rimine, (lane & 48) + 4 * tt + 2 * rp + 1)};
                        const f32x2 xc2 = (f32x2){bf2f(*(const LAS bf16_t*)(lds + ML_XC + swz256(tau0, e >> 3) + 2 * (e & 7))), bf2f(*(const LAS bf16_t*)(lds + ML_XC + swz256(tau1, e >> 3) + 2 * (e & 7)))};
                        const f32x2 op2 = (f32x2){opr[tt * 4 + 2 * rp], opr[tt * 4 + 2 * rp + 1]}, h2 = (f32x2){hacc[tt][2 * rp], hacc[tt][2 * rp + 1]};
                        const f32x2 num = __builtin_elementwise_fma(h2 * ri2, (f32x2){ng, ng}, (f32x2){sk, sk} * xc2);
                        const f32x2 tq2 = op2 * (f32x2){-1.4426950408889634f, -1.4426950408889634f}; const f32x2 den = (f32x2){fexp2(tq2.x), fexp2(tq2.y)} + (f32x2){1.0f, 1.0f};
                        const f32x2 y2 = num * (f32x2){frcp(den.x), frcp(den.y)};
                        yp0_[(dir ? -tau0r : tau0r) * KP] = f2bf(y2.x); yp0_[(dir ? -(tau0r + 1) : (tau0r + 1)) * KP] = f2bf(y2.y); }
            }
            if (ci < 16) asm volatile("s_waitcnt vmcnt(0)" ::: "memory");
            __syncthreads();
            if (ci < 16 && tid == 0) __hip_atomic_store(prog_mine, (unsigned)(ci + 1), __ATOMIC_RELAXED, __HIP_MEMORY_SCOPE_AGENT);
        }
    }
}

#undef ML_LANES
#undef ML_PREFETCH
__global__ void __launch_bounds__(NWAVES * 64, 2) mk_fwd(MkArgs args) {
    extern __shared__ __attribute__((aligned(16))) unsigned char lds_raw[];
    LAS unsigned char* lds = (LAS unsigned char*)lds_raw;
    const int tid = threadIdx.x, lane = tid & 63, wave = __builtin_amdgcn_readfirstlane(tid >> 6);
    const int G = gridDim.x, bx = blockIdx.x;
    unsigned char* ws = args.ws;
    volatile LAS unsigned* MISC = (volatile LAS unsigned*)(lds + MISC_OFF);
    if (tid < 64) MISC[tid] = 0u;
    __syncthreads();
    XcdBarrier bar = xcd_barrier_post((unsigned*)(ws + WS_CTL) + 4096 + args.li * 4096, MISC + 8);
    const int lo = args.ph_lo, hi = args.ph_hi;
#define IN(k) (lo <= (k) && (k) < hi)
#define SEAM(k) do { if (IN(k) && IN((k) + 1)) xcd_barrier(bar); } while (0)

    if (IN(0)) p0_phase(args, lds, G, bx, tid, lane, wave);
    SEAM(0);
    if (IN(1)) norm_phase<0>(args, lds, G, bx, tid, lane, wave);
    SEAM(1);
    if (IN(2)) {
        unsigned voffA[2][2], voffB[2]; pg::plain_voff(voffA[0], KP, false); voffA[1][0] = voffA[0][0]; voffA[1][1] = voffA[0][1]; pg::head_voff(voffB, KP);
        P2Tiles TS{(const char*)(ws + WS_HB), (const char*)(ws + WS_WIN), G, bx}; P2Epi E{(bf16_t*)(ws + WS_XM), args.in[15], args.in[16], G, bx};
        pg::gemm_stream<true>(lds, D, TS, E, voffA, voffB);
    }
    SEAM(2);
    if (IN(3)) {
        if (bx < 128) { if (args.pad != 2) mlstm_unit(args, lds, bx, tid, lane, wave); }
        else if (args.pad != 1) { attn_unit(args, lds, bx - 128, (bx - 128) * 8 + wave, 24, 0, tid, lane, wave); attn_unit(args, lds, bx, 24576 + (bx - 128) * 8 + wave, 12, 1, tid, lane, wave); }
    }
    SEAM(3);
    if (IN(4)) {
        unsigned voffA[2][2], voffB[2]; pg::plain_voff(voffA[0], KP, false); voffA[1][0] = voffA[0][0]; voffA[1][1] = voffA[0][1]; pg::plain_voff(voffB, KP, true);
        P4Tiles TS{(const char*)(ws + WS_YCAT), (const char*)(ws + WS_WOUT), G, bx}; P4Epi E{(const float*)(ws + WS_MOD), (bf16_t*)(ws + WS_MIX), G, bx};
        pg::gemm_stream<true>(lds, D, TS, E, voffA, voffB);
    }
    SEAM(4);
    if (IN(5)) norm_phase<1>(args, lds, G, bx, tid, lane, wave);
    SEAM(5);
    LAS int* idxs = (LAS int*)(lds + TAB_OFF); LAS float* gsl = (LAS float*)(lds + TAB_OFF + 1024);
    if (IN(6)) {
        const int be = bx, b = (be >> 4) & 15, e = be & 15;
        topk_select((const float*)(ws + WS_AFF) + (size_t)be * S, (LAS unsigned*)lds, idxs, gsl, (float*)(ws + WS_GSEL) + (size_t)be * CAP, (unsigned short*)(ws + WS_INV) + (size_t)be * S, tid, lane, wave);
        unsigned char* hid = ws + WS_HID + (size_t)be * CAP * HIDPB;
        unsigned voffA[2][2], voffB[2];
#pragma unroll
        for (int i = 0; i < 2; ++i) { int R, C; int tz = threadIdx.x; asm volatile("" : "+v"(tz)); pg::stage_rc(tz * 16 + i * 8192, R, C); voffA[0][i] = (unsigned)(idxs[R] * KPB + 2 * C); voffA[1][i] = (unsigned)(idxs[128 + R] * KPB + 2 * C); }
        pg::plain_voff(voffB, KPB / 2, true);
        const float* fsc = (const float*)(ws + WS_FSC);
        F1Epi8w E{hid, fsc[(2 * e) * 2 + 1], fsc[(2 * e + 1) * 2 + 1]};
        F1Tiles8w TS{(const char*)(ws + WS_HB) + (size_t)b * S * KPB, (const char*)(ws + WS_WG) + (size_t)e * DFF * KPB, (const char*)(ws + WS_WU) + (size_t)e * DFF * KPB, 16};
        gemm8w<8>(lds, TS, E, voffA, voffB);
    }
    if (IN(6) && IN(7)) { asm volatile("s_waitcnt vmcnt(0)" ::: "memory"); __syncthreads(); }
    if (IN(7)) {
        const int be = bx, e = be & 15;
        unsigned voffA[2][2], voffB[2]; pg::plain_voff(voffA[0], HIDPB / 2, false); voffA[1][0] = voffA[0][0]; voffA[1][1] = voffA[0][1]; pg::plain_voff(voffB, HIDPB / 2, true);
        const float* fsc = (const float*)(ws + WS_FSC);
        F2TilesL TS{(const char*)(ws + WS_HID) + (size_t)be * CAP * HIDPB, (const char*)(ws + WS_WD) + (size_t)e * D * HIDPB, 4};
        F2EpiL E{y_unit(ws, be), (const float*)(ws + WS_GSEL) + (size_t)be * CAP, fsc[(32 + e) * 2 + 1] * (Y_SCALE / HID_SCALE)};
        gemm8w<16>(lds, TS, E, voffA, voffB);
    }
    SEAM(7);
    if (IN(8)) {
        const unsigned short* inv = (const unsigned short*)(ws + WS_INV);
        const int gw = bx * 8 + wave, m0 = gw * 16, b = m0 >> 11, s0 = m0 & 2047;
        const float* g2 = (const float*)(ws + WS_MOD) + (size_t)b * 6144 + 5120 + 16 * lane;
        f32x4 gv[4];
#pragma unroll
        for (int j = 0; j < 4; ++j) gv[j] = *(const f32x4*)(g2 + 4 * j) * (1.0f / Y_SCALE);
        unsigned ivr[4];
#pragma unroll
        for (int j = 0; j < 4; ++j) ivr[j] = inv[(size_t)(b * 16 + (lane & 15)) * S + s0 + 4 * (lane >> 4) + j];
#pragma unroll 2
        for (int i = 0; i < 16; ++i) { const int m = m0 + i;
            float* orow = args.out + (size_t)m * D + 16 * lane;
            f32x4 xv[4];
            { const bf16_t* xrow = (const bf16_t*)(ws + WS_X1B) + (size_t)m * D + 16 * lane; const u32x4 xa = *(const u32x4*)xrow, xb = *(const u32x4*)(xrow + 8);
              xv[0] = (f32x4){__uint_as_float(xa.x << 16), __uint_as_float(xa.x & 0xffff0000u), __uint_as_float(xa.y << 16), __uint_as_float(xa.y & 0xffff0000u)};
              xv[1] = (f32x4){__uint_as_float(xa.z << 16), __uint_as_float(xa.z & 0xffff0000u), __uint_as_float(xa.w << 16), __uint_as_float(xa.w & 0xffff0000u)};
              xv[2] = (f32x4){__uint_as_float(xb.x << 16), __uint_as_float(xb.x & 0xffff0000u), __uint_as_float(xb.y << 16), __uint_as_float(xb.y & 0xffff0000u)};
              xv[3] = (f32x4){__uint_as_float(xb.z << 16), __uint_as_float(xb.z & 0xffff0000u), __uint_as_float(xb.w << 16), __uint_as_float(xb.w & 0xffff0000u)}; }
            const unsigned ivsel = (i & 3) == 0 ? ivr[0] : ((i & 3) == 1 ? ivr[1] : ((i & 3) == 2 ? ivr[2] : ivr[3]));
            float accv[16];
#pragma unroll
            for (int j = 0; j < 16; ++j) accv[j] = 0.f;
            unsigned msk = (unsigned)((__ballot(ivsel != 0xFFFFu) >> (16 * (i >> 2))) & 0xFFFFull);
            while (msk) {
                int ee[4]; bool hv[4];
#pragma unroll
                for (int q = 0; q < 4; ++q) { hv[q] = msk != 0u; ee[q] = hv[q] ? (int)__builtin_ctz(msk) : 0; if (hv[q]) msk &= msk - 1u; }
                u32x4 y0[4];
#pragma unroll
                for (int q = 0; q < 4; ++q) if (hv[q]) { const unsigned c = (unsigned)__shfl((int)ivsel, 16 * (i >> 2) + ee[q]); const unsigned char* yr = y_unit(ws, b * 16 + ee[q]) + (size_t)c * D + 16 * lane; y0[q] = *(const u32x4*)yr; }
#pragma unroll
                for (int q = 0; q < 4; ++q) if (hv[q]) {
#pragma unroll
                    for (int j = 0; j < 4; ++j) { const f32x2 lo = __builtin_amdgcn_cvt_pk_f32_fp8((int)y0[q][j], false), hi = __builtin_amdgcn_cvt_pk_f32_fp8((int)y0[q][j], true);
                        accv[4 * j] += lo.x; accv[4 * j + 1] += lo.y; accv[4 * j + 2] += hi.x; accv[4 * j + 3] += hi.y; } }
            }
#pragma unroll
            for (int j = 0; j < 4; ++j) *(f32x4*)(orow + 4 * j) = xv[j] + gv[j] * (f32x4){accv[4 * j], accv[4 * j + 1], accv[4 * j + 2], accv[4 * j + 3]}; }
    }
#undef IN
#undef SEAM
}

extern "C" void kernel_launch(void* const* d_in, const int* in_sizes, int n_in, void* d_out, int out_size, void* d_ws, size_t ws_size, hipStream_t stream) {
    static int ok = 0;
    if (!ok) {
        if (n_in != 25 || in_sizes[0] != T * D || out_size != T * D || ws_size < WS_END) { fprintf(stderr, "kernel_launch: unexpected shapes (n_in %d, in0 %d, out %d, ws %zu)\n", n_in, n_in > 0 ? in_sizes[0] : -1, out_size, ws_size); ok = -1; return; }
        if (hipFuncSetAttribute((const void*)mk_fwd, hipFuncAttributeMaxDynamicSharedMemorySize, LDS_BYTES) != hipSuccess) { fprintf(stderr, "hipFuncSetAttribute(mk_fwd) failed\n"); ok = -1; return; }
        { int dev = 0, cus = 0, per_cu = 0; hipGetDevice(&dev); hipDeviceGetAttribute(&cus, hipDeviceAttributeMultiprocessorCount, dev);
          hipOccupancyMaxActiveBlocksPerMultiprocessor(&per_cu, (const void*)mk_fwd, NWAVES * 64, LDS_BYTES); (void)hipGetLastError();
          if (cus < 256 || per_cu < 1) { fprintf(stderr, "kernel_launch: needs 256 CUs with one resident 512-thread workgroup each (cus %d, per_cu %d)\n", cus, per_cu); ok = -1; return; } }
        ok = 1;
    }
    if (ok < 0) return;
    unsigned char* ws = (unsigned char*)d_ws; float* out = (float*)d_out;
    hipMemsetAsync(ws + WS_CTL, 0, 1 * MiB, stream);
    int nl = 0; MkArgs ma{}; for (int i = 0; i < 25; ++i) ma.in[i] = (const float*)d_in[i]; ma.out = out; ma.ws = ws;
#define MKM(lo_, hi_, md_) do { ma.pad = (md_); MK(lo_, hi_); ma.pad = 0; } while (0)
#define MK(lo_, hi_) do { ma.ph_lo = (lo_); ma.ph_hi = (hi_); ma.li = nl++; hipLaunchKernelGGL(mk_fwd, dim3(256), dim3(NWAVES * 64), LDS_BYTES, stream, ma); } while (0)
    MK(0, 9);
}
```
